# Optimizing an MI355X kernel written in HIP

```python
import jax, jax.numpy as jnp
from jax import lax
import numpy as np

D_MODEL = 1024
BATCH = 16
SEQ = 4096
DEPTH = 1

CHUNK = 64
GMLP_BLOCK = 128
GMLP_GROUPS = 4
GMLP_GROUP_WIDTH = 128
GMLP_WIDTH = GMLP_GROUPS * GMLP_GROUP_WIDTH
MLA_HEADS = 8
QK_NOPE_DIM = 64
QK_ROPE_DIM = 32
QK_HEAD_DIM = QK_NOPE_DIM + QK_ROPE_DIM
V_HEAD_DIM = 64
Q_LORA_RANK = 256
KV_LORA_RANK = 128
MLA_WIDTH = MLA_HEADS * V_HEAD_DIM
MIX_WIDTH = GMLP_WIDTH + MLA_WIDTH
ROPE_THETA = 10000.0
Q_BLOCK = 128
IN_PROJ_OFFSETS = (512, 1024, 1280, 1408)
IN_PROJ_WIDTH = 1440
FFN_HIDDEN = 2816
RMS_EPS = 1e-6

kernel_name = "hybrid_gmlp_mla_macaron_block"


def rmsnorm(x, g):
    xf = x.astype(jnp.float32)
    y = xf * lax.rsqrt(jnp.mean(xf * xf, axis=-1, keepdims=True) + RMS_EPS)
    return (y * g.astype(jnp.float32)).astype(x.dtype)


def swiglu(h, w_gate, w_up, w_down):
    return (jax.nn.silu(h @ w_gate) * (h @ w_up)) @ w_down


def rope_tables(positions):
    inv_freq = ROPE_THETA ** (-jnp.arange(0, QK_ROPE_DIM, 2, dtype=jnp.float32) / QK_ROPE_DIM)
    ang = positions.astype(jnp.float32)[..., None] * inv_freq
    return jnp.cos(ang)[:, :, None, :], jnp.sin(ang)[:, :, None, :]


def apply_rope(x, cos, sin):
    xf = x.astype(jnp.float32)
    half = QK_ROPE_DIM // 2
    x1, x2 = xf[..., :half], xf[..., half:]
    return jnp.concatenate([x1 * cos - x2 * sin, x2 * cos + x1 * sin], axis=-1).astype(x.dtype)


def gmlp_mixer(u, v, v_norm, w_s, b_s):
    B, S, _ = u.shape
    nb = S // GMLP_BLOCK
    u = jax.nn.gelu(u)
    v = rmsnorm(jax.nn.gelu(v).reshape(B, S, GMLP_GROUPS, GMLP_GROUP_WIDTH), v_norm)
    v = v.reshape(B, nb, GMLP_BLOCK, GMLP_GROUPS, GMLP_GROUP_WIDTH)
    pos = jnp.arange(GMLP_BLOCK)
    mask = (pos[None, :] // CHUNK) <= (pos[:, None] // CHUNK)
    w = jnp.where(mask[None], w_s, jnp.zeros_like(w_s))
    mixed = jnp.einsum('gij,bnjgc->bnigc', w, v) + b_s.T[None, None, :, :, None]
    return u * mixed.reshape(B, S, GMLP_WIDTH)


def block_causal_attention(q, k, v):
    B, S, H, Dq = q.shape
    nqb = S // Q_BLOCK
    q_blocks = (q * (Dq ** -0.5)).reshape(B, nqb, Q_BLOCK, H, Dq).transpose(1, 0, 2, 3, 4)
    k_chunk = jnp.arange(S) // CHUNK

    def one_block(args):
        qb, idx = args
        q_chunk = (idx * Q_BLOCK + jnp.arange(Q_BLOCK)) // CHUNK
        mask = k_chunk[None, :] <= q_chunk[:, None]
        s = jnp.einsum('bqhd,bkhd->bhqk', qb, k).astype(jnp.float32)
        s = jnp.where(mask[None, None], s, -1e30)
        p = jax.nn.softmax(s, axis=-1).astype(v.dtype)
        return jnp.einsum('bhqk,bkhd->bqhd', p, v)

    out = lax.map(one_block, (q_blocks, jnp.arange(nqb)))
    return out.transpose(1, 0, 2, 3, 4).reshape(B, S, H, v.shape[-1])


def mla_mixer(c_q, c_kv, k_rope, cos, sin, q_latent_norm, w_uq, kv_latent_norm, w_ukv,
              q_head_norm, k_head_norm):
    B, S, _ = c_q.shape
    q = (rmsnorm(c_q, q_latent_norm) @ w_uq).reshape(B, S, MLA_HEADS, QK_HEAD_DIM)
    kv = (rmsnorm(c_kv, kv_latent_norm) @ w_ukv).reshape(B, S, MLA_HEADS, QK_NOPE_DIM + V_HEAD_DIM)
    k_nope, v = kv[..., :QK_NOPE_DIM], kv[..., QK_NOPE_DIM:]
    k_r = jnp.broadcast_to(k_rope[:, :, None, :], (B, S, MLA_HEADS, QK_ROPE_DIM))
    k = jnp.concatenate([k_nope, k_r], axis=-1)
    q = rmsnorm(q, q_head_norm)
    k = rmsnorm(k, k_head_norm)
    q = jnp.concatenate([q[..., :QK_NOPE_DIM], apply_rope(q[..., QK_NOPE_DIM:], cos, sin)], axis=-1)
    k = jnp.concatenate([k[..., :QK_NOPE_DIM], apply_rope(k[..., QK_NOPE_DIM:], cos, sin)], axis=-1)
    out = block_causal_attention(q, k, v)
    return out.reshape(B, S, MLA_WIDTH)


def setup_inputs(seed: int = 0) -> dict:
    key = jax.random.key(seed)
    ks = jax.random.split(key, 32)
    f32 = jnp.float32

    def w(k, shape, fan_in):
        return jax.random.normal(k, shape, f32) * (fan_in ** -0.5)

    def gain(k, shape):
        return 1.0 + 0.01 * jax.random.normal(k, shape, f32)

    L = DEPTH
    x = jax.random.normal(ks[0], (BATCH, SEQ, D_MODEL), f32)
    offsets = jax.random.randint(ks[1], (BATCH, 1), 0, 64, dtype=jnp.int32) * CHUNK
    positions = (offsets + jnp.arange(SEQ, dtype=jnp.int32)[None, :]).astype(jnp.int32)
    return {
        "x": x,
        "positions": positions,
        "ffn1_norm": gain(ks[2], (L, D_MODEL)),
        "ffn1_w_gate": w(ks[3], (L, D_MODEL, FFN_HIDDEN), D_MODEL),
        "ffn1_w_up": w(ks[4], (L, D_MODEL, FFN_HIDDEN), D_MODEL),
        "ffn1_w_down": w(ks[5], (L, FFN_HIDDEN, D_MODEL), FFN_HIDDEN),
        "mix_norm": gain(ks[6], (L, D_MODEL)),
        "w_in": w(ks[7], (L, D_MODEL, IN_PROJ_WIDTH), D_MODEL),
        "gmlp_v_norm": gain(ks[8], (L, GMLP_GROUPS, GMLP_GROUP_WIDTH)),
        "gmlp_w_s": w(ks[9], (L, GMLP_GROUPS, GMLP_BLOCK, GMLP_BLOCK), GMLP_BLOCK),
        "gmlp_b_s": gain(ks[10], (L, GMLP_GROUPS, GMLP_BLOCK)),
        "q_latent_norm": gain(ks[11], (L, Q_LORA_RANK)),
        "w_uq": w(ks[12], (L, Q_LORA_RANK, MLA_HEADS * QK_HEAD_DIM), Q_LORA_RANK),
        "kv_latent_norm": gain(ks[13], (L, KV_LORA_RANK)),
        "w_ukv": w(ks[14], (L, KV_LORA_RANK, MLA_HEADS * (QK_NOPE_DIM + V_HEAD_DIM)), KV_LORA_RANK),
        "q_head_norm": gain(ks[15], (L, QK_HEAD_DIM)),
        "k_head_norm": gain(ks[16], (L, QK_HEAD_DIM)),
        "gmlp_out_norm": gain(ks[17], (L, GMLP_WIDTH)),
        "mla_out_norm": gain(ks[18], (L, MLA_WIDTH)),
        "w_out": w(ks[19], (L, MIX_WIDTH, D_MODEL), MIX_WIDTH),
        "ffn2_norm": gain(ks[20], (L, D_MODEL)),
        "ffn2_w_gate": w(ks[21], (L, D_MODEL, FFN_HIDDEN), D_MODEL),
        "ffn2_w_up": w(ks[22], (L, D_MODEL, FFN_HIDDEN), D_MODEL),
        "ffn2_w_down": w(ks[23], (L, FFN_HIDDEN, D_MODEL), FFN_HIDDEN),
        "final_norm": gain(ks[24], (L, D_MODEL)),
    }


def reference(x, positions, ffn1_norm, ffn1_w_gate, ffn1_w_up, ffn1_w_down, mix_norm, w_in,
              gmlp_v_norm, gmlp_w_s, gmlp_b_s, q_latent_norm, w_uq, kv_latent_norm, w_ukv,
              q_head_norm, k_head_norm, gmlp_out_norm, mla_out_norm, w_out,
              ffn2_norm, ffn2_w_gate, ffn2_w_up, ffn2_w_down, final_norm):
    cos, sin = rope_tables(positions)
    o1, o2, o3, o4 = IN_PROJ_OFFSETS
    for l in range(DEPTH):
        x = x + 0.5 * swiglu(rmsnorm(x, ffn1_norm[l]), ffn1_w_gate[l], ffn1_w_up[l], ffn1_w_down[l])
        h = rmsnorm(x, mix_norm[l]) @ w_in[l]
        u, v = h[..., :o1], h[..., o1:o2]
        c_q, c_kv, k_rope = h[..., o2:o3], h[..., o3:o4], h[..., o4:]
        y_a = gmlp_mixer(u, v, gmlp_v_norm[l], gmlp_w_s[l], gmlp_b_s[l])
        y_b = mla_mixer(c_q, c_kv, k_rope, cos, sin, q_latent_norm[l], w_uq[l],
                        kv_latent_norm[l], w_ukv[l], q_head_norm[l], k_head_norm[l])
        y = jnp.concatenate([rmsnorm(y_a, gmlp_out_norm[l]), rmsnorm(y_b, mla_out_norm[l])], axis=-1)
        x = x + y @ w_out[l]
        x = x + 0.5 * swiglu(rmsnorm(x, ffn2_norm[l]), ffn2_w_gate[l], ffn2_w_up[l], ffn2_w_down[l])
        x = rmsnorm(x, final_norm[l])
    return x
```

```cpp
#include <hip/hip_runtime.h>
#include <hip/hip_cooperative_groups.h>
#include <cstdio>
#include <cstdint>
namespace cg = cooperative_groups;
#ifndef MK_COOP
#define MK_COOP 1
#endif
__device__ __forceinline__ int opaque_tid() { int t = threadIdx.x; asm volatile("" : "+v"(t)); return t; }
namespace pg8 {
#define PG8_LAS __attribute__((address_space(3)))
typedef unsigned short bf16_t;
typedef short bf16x8 __attribute__((ext_vector_type(8)));
typedef float f32x4 __attribute__((ext_vector_type(4)));
typedef unsigned u32x4 __attribute__((ext_vector_type(4)));
constexpr int BM = 256, BK = 64, HALF = 128, HTB = HALF * BK * 2  , STAGE_BYTES = 8 * HTB, NXCD = 8, WGM = 4;

__host__ __device__ __forceinline__ int lds_byte(int r, int c) { const int st = (r >> 4) * 2 + (c >> 5), rr = r & 15, cc = c & 31, ob = rr * 64 + cc * 2; return st * 1024 + (ob ^ (((ob >> 9) & 1) << 5)); }
__host__ __device__ __forceinline__ void stage_rc(int b, int& R, int& C) { const int st = b / 1024, sb = b % 1024, swz = sb ^ (((sb >> 9) & 1) << 5); R = (st >> 1) * 16 + swz / 64; C = (st & 1) * 32 + (swz % 64) / 2; }
__host__ __device__ __forceinline__ int perm32(int rho) { const int n = rho >> 4, i = rho & 15; return 8 * (i >> 2) + 4 * n + (i & 3); }

struct Unit { int pm, pn; };
struct Gemm { const bf16_t* A; const bf16_t* Bt; int M, N, K; };

struct StaticOrder {
    int nM, nN, nwg, G, c;
    __host__ __device__ void init(int M, int N, int G_, int c_) { nM = M / BM; nN = N / BM; nwg = nM * nN; G = G_; c = c_; }
    __host__ __device__ bool next(int i, Unit& u) const {
        const long L = (long)i * G + c; if (L >= nwg) return false;
        int wgid = (int)L; { const int q = nwg / NXCD, r = nwg % NXCD, xcd = wgid % NXCD, off = wgid / NXCD; wgid = (xcd < r ? xcd * (q + 1) : r * (q + 1) + (xcd - r) * q) + off; }
        const int nig = WGM * nN, gid = wgid / nig, fm = gid * WGM, gsz = (nM - fm) < WGM ? (nM - fm) : WGM;
        u.pm = fm + ((wgid % nig) % gsz); u.pn = (wgid % nig) / gsz; return true;
    }
    __device__ __forceinline__ void a_ready(const Unit&) const {}
    __device__ __forceinline__ void done(const Unit&) const {}
};

__device__ __forceinline__ unsigned cvt_pk_bf16(float lo, float hi) { unsigned r; asm volatile("v_cvt_pk_bf16_f32 %0, %1, %2" : "=v"(r) : "v"(lo), "v"(hi)); return r; }
template <class Epi, class Sched, bool ALIGN_EPI = false, bool SP2 = false, bool ABLK = false>
__device__ __forceinline__ void gemm_phase(PG8_LAS unsigned char* lds, const Gemm g, const Sched& S, const Epi& E) {
    const int tid = ::opaque_tid(), wid = __builtin_amdgcn_readfirstlane(tid >> 6), lane = tid & 63, wr = wid >> 2, wc = wid & 3, fr = lane & 15, fq = lane >> 4;
    const int K = g.K, nt = K / BK;
    unsigned voffA[2], voffB[2];
#pragma unroll
    for (int i = 0; i < 2; ++i) { int R, C; stage_rc(tid * 16 + i * 8192, R, C); const int Rb = Epi::PERM ? ((R & ~31) + perm32(R & 31)) : R;
        voffA[i] = ABLK ? (unsigned)(R * BK + C) * 2u : (unsigned)(R * K + C) * 2u; voffB[i] = (unsigned)(Rb * K + C) * 2u; }
    const size_t kstep = (size_t)(BK * 2);
    const size_t hstep = (size_t)HALF * K * 2;
    const size_t tstep = 2 * hstep;
    const size_t kstepA = ABLK ? (size_t)(BM * BK * 2) : kstep, hstepA = ABLK ? (size_t)(HALF * BK * 2) : hstep;
    const unsigned ldsw = (unsigned)wid * 1024u;
    const int aoff = lds_byte(wr * 64 + fr, fq * 8), boff = lds_byte(wc * 32 + fr, fq * 8);
#define PG8_SA(b, h) (((b) * 2 + (h)) * HTB)
#define PG8_SB(b, h) ((4 + (b) * 2 + (h)) * HTB)
#define PG8_STAGE(bufoff, gbase, voff) do { _Pragma("unroll") for (int _i = 0; _i < 2; ++_i) \
        __builtin_amdgcn_global_load_lds((const unsigned*)((const char*)(gbase) + (voff)[_i]), (PG8_LAS unsigned*)(lds + (bufoff) + ldsw + _i * 8192), 16, 0, 0); } while (0)
#define PG8_LDA(dst, b, h) do { _Pragma("unroll") for (int m = 0; m < 4; ++m) _Pragma("unroll") for (int k = 0; k < 2; ++k) dst[m][k] = *(const PG8_LAS bf16x8*)(lds + PG8_SA(b, h) + aoff + m * 2048 + k * 1024); } while (0)
#define PG8_LDB(dst, b, h) do { _Pragma("unroll") for (int n = 0; n < 2; ++n) _Pragma("unroll") for (int k = 0; k < 2; ++k) dst[n][k] = *(const PG8_LAS bf16x8*)(lds + PG8_SB(b, h) + boff + n * 2048 + k * 1024); } while (0)
#define PG8_MMA(ai, bj, At, Bt) do { __builtin_amdgcn_s_setprio(1); _Pragma("unroll") for (int m = 0; m < 4; ++m) _Pragma("unroll") for (int n = 0; n < 2; ++n) _Pragma("unroll") for (int k = 0; k < 2; ++k) \
        acc[ai][bj][m][n] = __builtin_amdgcn_mfma_f32_16x16x32_bf16(Bt[n][k], At[m][k], acc[ai][bj][m][n], 0, 0, 0); __builtin_amdgcn_s_setprio(0); } while (0)
#define PG8_WAIT_V(n) asm volatile("s_waitcnt vmcnt(" #n ")" ::: "memory")
#define PG8_WAIT_L(n) asm volatile("s_waitcnt lgkmcnt(" #n ")" ::: "memory")
#define PG8_BAR __builtin_amdgcn_s_barrier()
#define PG8_SCHED __builtin_amdgcn_sched_barrier(0)
    Unit cur, nxt; int ui = 0;
    if (!S.next(0, cur)) return;
    f32x4 acc[2][2][4][2];
#pragma unroll
    for (int a = 0; a < 2; ++a)
#pragma unroll
        for (int b = 0; b < 2; ++b)
#pragma unroll
            for (int m = 0; m < 4; ++m)
#pragma unroll
                for (int n = 0; n < 2; ++n) acc[a][b][m][n] = (f32x4){0.f, 0.f, 0.f, 0.f};
    bf16x8 At[4][2], B0[2][2], B1[2][2];
    const char* cA = (const char*)g.A + (size_t)cur.pm * tstep; const char* cB = (const char*)g.Bt + (size_t)cur.pn * tstep;
    S.a_ready(cur);
    if constexpr (SP2) {
        PG8_STAGE(PG8_SB(0, 0), cB, voffB); PG8_STAGE(PG8_SB(0, 1), cB + hstep, voffB); PG8_STAGE(PG8_SA(0, 0), cA, voffA); PG8_STAGE(PG8_SA(0, 1), cA + hstepA, voffA);
        if (wr == 1) PG8_BAR;
        PG8_WAIT_V(2); PG8_BAR;
        PG8_STAGE(PG8_SB(1, 0), cB + kstep, voffB); PG8_STAGE(PG8_SA(1, 0), cA + kstepA, voffA); PG8_STAGE(PG8_SB(1, 1), cB + hstep + kstep, voffB);
        PG8_WAIT_V(6); PG8_BAR;
    } else {
        PG8_STAGE(PG8_SB(0, 0), cB, voffB); PG8_STAGE(PG8_SA(0, 0), cA, voffA); PG8_STAGE(PG8_SB(0, 1), cB + hstep, voffB); PG8_STAGE(PG8_SA(0, 1), cA + hstepA, voffA);
        if (wr == 1) PG8_BAR;
        PG8_WAIT_V(4); PG8_BAR;
        PG8_STAGE(PG8_SB(1, 0), cB + kstep, voffB); PG8_STAGE(PG8_SA(1, 0), cA + kstepA, voffA); PG8_STAGE(PG8_SB(1, 1), cB + hstep + kstep, voffB);
        PG8_WAIT_V(6); PG8_BAR;
    }
    for (;;) {
        const bool has_next = S.next(ui + 1, nxt);
        const char* nA = has_next ? (const char*)g.A + (size_t)nxt.pm * tstep : cA; const char* nB = has_next ? (const char*)g.Bt + (size_t)nxt.pn * tstep : cB;
        for (int t = 0; t < nt; t += 2) {
            const bool last = (t == nt - 2);
            const char* a1 = cA + (size_t)(t + 1) * kstepA;
            const char* a2 = last ? nA : cA + (size_t)(t + 2) * kstepA; const char* b2 = last ? nB : cB + (size_t)(t + 2) * kstep;
            const char* a3 = a2 + kstepA; const char* b3 = b2 + kstep;
            if (last && has_next) S.a_ready(nxt);
            if constexpr (SP2) {
            PG8_LDB(B0, 0, 0); PG8_LDB(B1, 0, 1); PG8_SCHED; PG8_LDA(At, 0, 0); PG8_STAGE(PG8_SA(1, 1), a1 + hstepA, voffA);
            PG8_WAIT_V(8); PG8_WAIT_L(0); PG8_BAR; PG8_MMA(0, 0, At, B0); PG8_MMA(0, 1, At, B1); PG8_BAR; PG8_SCHED;
            PG8_LDA(At, 0, 1); PG8_STAGE(PG8_SB(0, 0), b2, voffB); PG8_STAGE(PG8_SB(0, 1), b2 + hstep, voffB); PG8_STAGE(PG8_SA(0, 0), a2, voffA);
            PG8_WAIT_V(8); PG8_WAIT_L(0); PG8_BAR; PG8_MMA(1, 0, At, B0); PG8_MMA(1, 1, At, B1); PG8_BAR; PG8_SCHED;
            PG8_LDB(B0, 1, 0); PG8_LDB(B1, 1, 1); PG8_SCHED; PG8_LDA(At, 1, 0); PG8_STAGE(PG8_SA(0, 1), a2 + hstepA, voffA);
            PG8_WAIT_V(8); PG8_WAIT_L(0); PG8_BAR; PG8_MMA(0, 0, At, B0); PG8_MMA(0, 1, At, B1); PG8_BAR; PG8_SCHED;
            PG8_LDA(At, 1, 1); PG8_STAGE(PG8_SB(1, 0), b3, voffB); PG8_STAGE(PG8_SB(1, 1), b3 + hstep, voffB); PG8_STAGE(PG8_SA(1, 0), a3, voffA);
            PG8_WAIT_V(8); PG8_WAIT_L(0); PG8_BAR; PG8_MMA(1, 0, At, B0); PG8_MMA(1, 1, At, B1); PG8_BAR; PG8_SCHED;
            } else {
            PG8_LDB(B0, 0, 0); PG8_SCHED; PG8_LDA(At, 0, 0); PG8_STAGE(PG8_SA(1, 1), a1 + hstepA, voffA);
            PG8_WAIT_L(8); PG8_BAR; PG8_WAIT_L(0); PG8_MMA(0, 0, At, B0); PG8_BAR; PG8_SCHED;
            PG8_LDB(B1, 0, 1); PG8_STAGE(PG8_SB(0, 0), b2, voffB);
            PG8_BAR; PG8_WAIT_L(0); PG8_MMA(0, 1, At, B1); PG8_BAR;
            PG8_LDA(At, 0, 1); PG8_STAGE(PG8_SA(0, 0), a2, voffA);
            PG8_BAR; PG8_WAIT_L(0); PG8_MMA(1, 0, At, B0); PG8_BAR; PG8_SCHED;
            PG8_STAGE(PG8_SB(0, 1), b2 + hstep, voffB);
            PG8_WAIT_V(6); PG8_BAR; PG8_MMA(1, 1, At, B1); PG8_BAR;
            PG8_LDB(B0, 1, 0); PG8_SCHED; PG8_LDA(At, 1, 0); PG8_STAGE(PG8_SA(0, 1), a2 + hstepA, voffA);
            PG8_WAIT_L(8); PG8_BAR; PG8_WAIT_L(0); PG8_MMA(0, 0, At, B0); PG8_BAR; PG8_SCHED;
            PG8_LDB(B1, 1, 1); PG8_STAGE(PG8_SB(1, 0), b3, voffB);
            PG8_BAR; PG8_WAIT_L(0); PG8_MMA(0, 1, At, B1); PG8_BAR;
            PG8_LDA(At, 1, 1); PG8_STAGE(PG8_SA(1, 0), a3, voffA);
            PG8_BAR; PG8_WAIT_L(0); PG8_MMA(1, 0, At, B0); PG8_BAR; PG8_SCHED;
            PG8_STAGE(PG8_SB(1, 1), b3 + hstep, voffB);
            PG8_WAIT_V(6); PG8_BAR; PG8_MMA(1, 1, At, B1); PG8_BAR;
            }
            if constexpr (Epi::MIDK > 0) { if (t + 2 == Epi::MIDK) E.mid(acc, cur, wr, wc, fr, fq); }
        }
        if constexpr (ALIGN_EPI) { if (wr == 0) PG8_BAR; }
        if constexpr (!Epi::AFTER_DRAIN) { E(acc, cur, wr, wc, fr, fq); S.done(cur); }
        if (!has_next) break;
#pragma unroll
        for (int a = 0; a < 2; ++a)
#pragma unroll
            for (int b = 0; b < 2; ++b)
#pragma unroll
                for (int m = 0; m < 4; ++m)
#pragma unroll
                    for (int n = 0; n < 2; ++n) acc[a][b][m][n] = (f32x4){0.f, 0.f, 0.f, 0.f};
        cur = nxt; cA = nA; cB = nB; ++ui;
        if constexpr (ALIGN_EPI) { if (wr == 1) PG8_BAR; }
    }
    PG8_WAIT_V(0);
    if constexpr (!ALIGN_EPI) { if (wr == 0) PG8_BAR; }
    PG8_BAR;
    if constexpr (Epi::AFTER_DRAIN) { E.fused(acc, cur, wr, wc, fr, fq, lds, wid, lane); S.done(cur); }
#undef PG8_SA
#undef PG8_SB
#undef PG8_STAGE
#undef PG8_LDA
#undef PG8_LDB
#undef PG8_MMA
#undef PG8_WAIT_V
#undef PG8_WAIT_L
#undef PG8_BAR
#undef PG8_SCHED
}
}

#define LAS __attribute__((address_space(3)))
typedef unsigned short bf16_t;
typedef short bf16x8 __attribute__((ext_vector_type(8)));
typedef float f32x2 __attribute__((ext_vector_type(2)));
typedef float f32x4 __attribute__((ext_vector_type(4)));
typedef float f32x16 __attribute__((ext_vector_type(16)));
typedef unsigned u32x2 __attribute__((ext_vector_type(2)));
typedef unsigned u32x4 __attribute__((ext_vector_type(4)));


constexpr int M = 65536, SEQ = 4096, D = 1024, FF = 2816, NGU = 2 * FF, NINP = 1536, NIN = 1440;
constexpr float EPS = 1e-6f;
constexpr int LDS_BYTES = 135168;
constexpr size_t MiB = 1u << 20;
constexpr size_t WS_WGU1 = 0, WS_WD1 = 11 * MiB, WS_WGU2 = 17 * MiB, WS_WD2 = 28 * MiB, WS_WIN = 34 * MiB, WS_WOUT = 37 * MiB,
                 WS_WUQ = 39 * MiB, WS_WUKV = 40 * MiB, WS_WSM = 41 * MiB, WS_COS = 42 * MiB, WS_SIN = 46 * MiB;
constexpr size_t WS_BAR = 52 * MiB;
constexpr size_t WS_SS = 50 * MiB;
constexpr size_t WS_XN = 64 * MiB;
constexpr size_t WS_HID = 192 * MiB;
constexpr size_t WS_GU = 192 * MiB, WS_GV = 256 * MiB, WS_CQN = 448 * MiB, WS_CKVN = 480 * MiB, WS_KR = 496 * MiB;
constexpr size_t WS_QRAW = 544 * MiB, WS_KVRAW = 640 * MiB, WS_QF = 768 * MiB, WS_KF = 864 * MiB, WS_VT = 960 * MiB, WS_END = 1024 * MiB;
constexpr size_t WS_Y = WS_KVRAW;

struct Params { const float* in[25]; float* out; unsigned char* ws; int ph_lo, ph_hi; };

__device__ __forceinline__ unsigned cvt_pk(float lo, float hi) { unsigned r; asm volatile("v_cvt_pk_bf16_f32 %0, %1, %2" : "=v"(r) : "v"(lo), "v"(hi)); return r; }
__device__ __forceinline__ float bflo(unsigned w) { return __builtin_bit_cast(float, w << 16); }
__device__ __forceinline__ float bfhi(unsigned w) { return __builtin_bit_cast(float, w & 0xffff0000u); }
__device__ __forceinline__ float bf2f(bf16_t h) { return __builtin_bit_cast(float, (unsigned)h << 16); }
__device__ __forceinline__ float wave_sum(float v) {
#pragma unroll
    for (int o = 1; o < 64; o <<= 1) v += __shfl_xor(v, o);
    return v;
}
__device__ __forceinline__ float silu_f(float g) { return g * __builtin_amdgcn_rcpf(1.f + __builtin_amdgcn_exp2f(-1.4426950408889634f * g)); }
__device__ __forceinline__ float gelu_f(float x) {
    const float t = x * (1.f + 0.044715f * x * x);
    return x * __builtin_amdgcn_rcpf(1.f + __builtin_amdgcn_exp2f(-2.3022081986f * t));
}
__device__ __forceinline__ float sq4(f32x4 a) { return (a.x * a.x + a.y * a.y) + (a.z * a.z + a.w * a.w); }
__device__ __forceinline__ u32x4 pack8(f32x4 a, f32x4 b) { u32x4 o; o.x = cvt_pk(a.x, a.y); o.y = cvt_pk(a.z, a.w); o.z = cvt_pk(b.x, b.y); o.w = cvt_pk(b.z, b.w); return o; }


__device__ __forceinline__ float rstd_of(const float* SS, int row, float invw) { return 1.0f / sqrtf(SS[row] * invw + EPS); }
__device__ __forceinline__ void row_stat_add(float* SS, int row, float v, int fq) {
    v += __shfl_xor(v, 16); v += __shfl_xor(v, 32);
    if (fq == 0) unsafeAtomicAdd(SS + row, v);
}
template <bool SCALE> struct EpiSwiglu {
    static constexpr bool PERM = true, AFTER_DRAIN = false; static constexpr int MIDK = 0;
    bf16_t* H; const float* SS;
    __device__ __forceinline__ void operator()(const f32x4 (&acc)[2][2][4][2], const pg8::Unit& u, int wr, int wc, int fr, int fq) const {
        const int row0 = u.pm * 256 + wr * 64 + fr, col0 = u.pn * 128 + wc * 32 + 8 * fq;
        bf16_t* hb = H + (size_t)u.pm * 256 * FF + (size_t)(col0 >> 6) * (256 * 64) + (col0 & 63);
#pragma unroll
        for (int ai = 0; ai < 2; ++ai)
#pragma unroll
            for (int m = 0; m < 4; ++m) {
                const int row = row0 + ai * 128 + m * 16;
                const float r = SCALE ? rstd_of(SS, row, 1.f / 1024.f) : 1.f;
                const f32x4 g0 = acc[ai][0][m][0] * r, g1 = acc[ai][0][m][1] * r, u0 = acc[ai][1][m][0] * r, u1 = acc[ai][1][m][1] * r;
                f32x4 h0, h1;
                h0.x = silu_f(g0.x) * u0.x; h0.y = silu_f(g0.y) * u0.y; h0.z = silu_f(g0.z) * u0.z; h0.w = silu_f(g0.w) * u0.w;
                h1.x = silu_f(g1.x) * u1.x; h1.y = silu_f(g1.y) * u1.y; h1.z = silu_f(g1.z) * u1.z; h1.w = silu_f(g1.w) * u1.w;
                *(u32x4*)(hb + (wr * 64 + fr + ai * 128 + m * 16) * 64) = pack8(h0, h1);
            }
    }
};
template <bool RF32> struct EpiResid {
    static constexpr bool PERM = true, AFTER_DRAIN = false; static constexpr int MIDK = 0;
    const float* R; bf16_t* X; float* SS; float s;
    __device__ __forceinline__ void operator()(const f32x4 (&acc)[2][2][4][2], const pg8::Unit& u, int wr, int wc, int fr, int fq) const {
        const int row0 = u.pm * 256 + wr * 64 + fr, col0 = u.pn * 256 + wc * 32 + 8 * fq;
#pragma unroll
        for (int ai = 0; ai < 2; ++ai) {
            f32x4 r0[4][2], r1[4][2];
#pragma unroll
            for (int m = 0; m < 4; ++m)
#pragma unroll
                for (int bj = 0; bj < 2; ++bj) {
                    const size_t idx = (size_t)(row0 + ai * 128 + m * 16) * D + col0 + bj * 128;
                    if (RF32) { r0[m][bj] = *(const f32x4*)(R + idx); r1[m][bj] = *(const f32x4*)(R + idx + 4); }
                    else { const u32x4 w = *(const u32x4*)(X + idx); r0[m][bj] = (f32x4){bflo(w.x), bfhi(w.x), bflo(w.y), bfhi(w.y)}; r1[m][bj] = (f32x4){bflo(w.z), bfhi(w.z), bflo(w.w), bfhi(w.w)}; }
                }
            asm volatile("" ::: "memory");
#pragma unroll
            for (int m = 0; m < 4; ++m) {
                const int row = row0 + ai * 128 + m * 16; float ssq = 0.f;
#pragma unroll
                for (int bj = 0; bj < 2; ++bj) {
                    const size_t idx = (size_t)row * D + col0 + bj * 128;
                    const f32x4 v0 = r0[m][bj] + acc[ai][bj][m][0] * s, v1 = r1[m][bj] + acc[ai][bj][m][1] * s;
                    ssq += sq4(v0) + sq4(v1);
                    *(u32x4*)(X + idx) = pack8(v0, v1);
                }
                row_stat_add(SS, row, ssq, fq);
            }
        }
    }
};
struct EpiResidY {
    static constexpr bool PERM = true, AFTER_DRAIN = false; static constexpr int MIDK = 8;
    bf16_t* X; float* SS; const float* SSB; const LAS float* F;
    __device__ __forceinline__ void mid(f32x4 (&acc)[2][2][4][2], const pg8::Unit& u, int wr, int wc, int fr, int fq) const {
#pragma unroll
        for (int ai = 0; ai < 2; ++ai)
#pragma unroll
            for (int m = 0; m < 4; ++m) {
                const float f = F[wr * 64 + fr + ai * 128 + m * 16];
#pragma unroll
                for (int bj = 0; bj < 2; ++bj) { acc[ai][bj][m][0] = acc[ai][bj][m][0] * f; acc[ai][bj][m][1] = acc[ai][bj][m][1] * f; }
            }
    }
    __device__ __forceinline__ void operator()(const f32x4 (&acc)[2][2][4][2], const pg8::Unit& u, int wr, int wc, int fr, int fq) const {
        const int row0 = u.pm * 256 + wr * 64 + fr, col0 = u.pn * 256 + wc * 32 + 8 * fq;
#pragma unroll
        for (int ai = 0; ai < 2; ++ai) {
            u32x4 rw[4][2]; float rbv[4];
#pragma unroll
            for (int m = 0; m < 4; ++m) { rbv[m] = SSB[row0 + ai * 128 + m * 16];
#pragma unroll
                for (int bj = 0; bj < 2; ++bj) rw[m][bj] = *(const u32x4*)(X + (size_t)(row0 + ai * 128 + m * 16) * D + col0 + bj * 128); }
            asm volatile("" ::: "memory");
#pragma unroll
            for (int m = 0; m < 4; ++m) {
                const int row = row0 + ai * 128 + m * 16; float ssq = 0.f;
                const float rb = 1.0f / sqrtf(rbv[m] * (1.f / 512.f) + EPS);
#pragma unroll
                for (int bj = 0; bj < 2; ++bj) {
                    const size_t idx = (size_t)row * D + col0 + bj * 128;
                    const u32x4 w = rw[m][bj];
                    const f32x4 r0 = {bflo(w.x), bfhi(w.x), bflo(w.y), bfhi(w.y)}, r1 = {bflo(w.z), bfhi(w.z), bflo(w.w), bfhi(w.w)};
                    const f32x4 v0 = r0 + acc[ai][bj][m][0] * rb, v1 = r1 + acc[ai][bj][m][1] * rb;
                    ssq += sq4(v0) + sq4(v1);
                    *(u32x4*)(X + idx) = pack8(v0, v1);
                }
                row_stat_add(SS, row, ssq, fq);
            }
        }
    }
};
struct OrderY : pg8::StaticOrder {
    const float* SSA; const float* SSB; LAS float* F;
    __device__ __forceinline__ void a_ready(const pg8::Unit& u) const {
        const int t = threadIdx.x;
        if (t < 256) { const int row = u.pm * 256 + t; F[t] = sqrtf((SSB[row] * (1.f / 512.f) + EPS) / (SSA[row] * (1.f / 512.f) + EPS)); }
    }
};
struct EpiH {
    static constexpr bool PERM = true, AFTER_DRAIN = false; static constexpr int MIDK = 0;
    bf16_t* GU; bf16_t* GV; bf16_t* CQ; bf16_t* CKV; float* KR; const float* SS1; float* SSQ; float* SSKV;
    __device__ __forceinline__ void operator()(const f32x4 (&acc)[2][2][4][2], const pg8::Unit& u, int wr, int wc, int fr, int fq) const {
        const int row0 = u.pm * 256 + wr * 64 + fr, colw = wc * 32 + 8 * fq;
        if (u.pn < 4) {
            bf16_t* dst = (u.pn < 2 ? GU : GV) + (u.pn & 1) * 256 + colw;
#pragma unroll
            for (int ai = 0; ai < 2; ++ai)
#pragma unroll
                for (int m = 0; m < 4; ++m) {
                    const int row = row0 + ai * 128 + m * 16; const float r = rstd_of(SS1, row, 1.f / 1024.f);
#pragma unroll
                    for (int bj = 0; bj < 2; ++bj) {
                        const f32x4 a = acc[ai][bj][m][0] * r, b = acc[ai][bj][m][1] * r;
                        f32x4 ga, gb; ga.x = gelu_f(a.x); ga.y = gelu_f(a.y); ga.z = gelu_f(a.z); ga.w = gelu_f(a.w);
                        gb.x = gelu_f(b.x); gb.y = gelu_f(b.y); gb.z = gelu_f(b.z); gb.w = gelu_f(b.w);
                        *(u32x4*)(dst + (size_t)row * 512 + bj * 128) = pack8(ga, gb);
                    }
                }
        } else if (u.pn == 4) {
#pragma unroll
            for (int ai = 0; ai < 2; ++ai)
#pragma unroll
                for (int m = 0; m < 4; ++m) {
                    const int row = row0 + ai * 128 + m * 16; const float r = rstd_of(SS1, row, 1.f / 1024.f); float ssq = 0.f;
#pragma unroll
                    for (int bj = 0; bj < 2; ++bj) {
                        const f32x4 a = acc[ai][bj][m][0] * r, b = acc[ai][bj][m][1] * r; ssq += sq4(a) + sq4(b);
                        *(u32x4*)(CQ + (size_t)row * 256 + bj * 128 + colw) = pack8(a, b);
                    }
                    row_stat_add(SSQ, row, ssq, fq);
                }
        } else {
#pragma unroll
            for (int ai = 0; ai < 2; ++ai)
#pragma unroll
                for (int m = 0; m < 4; ++m) {
                    const int row = row0 + ai * 128 + m * 16; const float r = rstd_of(SS1, row, 1.f / 1024.f);
                    const f32x4 a = acc[ai][0][m][0] * r, b = acc[ai][0][m][1] * r;
                    *(u32x4*)(CKV + (size_t)row * 128 + colw) = pack8(a, b);
                    row_stat_add(SSKV, row, sq4(a) + sq4(b), fq);
                    if (wc == 0) { float* d = KR + (size_t)row * 32 + 8 * fq; *(f32x4*)d = acc[ai][1][m][0] * r; *(f32x4*)(d + 4) = acc[ai][1][m][1] * r; }
                }
        }
    }
};
struct EpiPlain {
    static constexpr bool PERM = true, AFTER_DRAIN = false; static constexpr int MIDK = 0;
    bf16_t* O; int ldc; const float* SS; float invw;
    __device__ __forceinline__ void operator()(const f32x4 (&acc)[2][2][4][2], const pg8::Unit& u, int wr, int wc, int fr, int fq) const {
        const int row0 = u.pm * 256 + wr * 64 + fr, col0 = u.pn * 256 + wc * 32 + 8 * fq;
#pragma unroll
        for (int ai = 0; ai < 2; ++ai)
#pragma unroll
            for (int m = 0; m < 4; ++m) {
                const int row = row0 + ai * 128 + m * 16; const float r = rstd_of(SS, row, invw);
#pragma unroll
                for (int bj = 0; bj < 2; ++bj)
                    *(u32x4*)(O + (size_t)row * ldc + col0 + bj * 128) = pack8(acc[ai][bj][m][0] * r, acc[ai][bj][m][1] * r);
            }
    }
};

__device__ __forceinline__ void tr_tile(const float* W, int ldw, const float* gain, bf16_t* dst, int dpitch, int mode, int tile, int nb, LAS float* scr, int lane) {
    const int kb = tile / nb, nbi = tile - kb * nb, k0 = kb * 64, n0 = nbi * 32;
    float wv[32];
#pragma unroll
    for (int i = 0; i < 32; ++i) wv[i] = W[(size_t)(k0 + 2 * i + (lane >> 5)) * ldw + n0 + (lane & 31)];
    if (gain) {
#pragma unroll
        for (int i = 0; i < 32; ++i) wv[i] *= gain[k0 + 2 * i + (lane >> 5)];
    }
#pragma unroll
    for (int i = 0; i < 32; ++i) scr[(2 * i + (lane >> 5)) * 33 + (lane & 31)] = wv[i];
    asm volatile("s_waitcnt lgkmcnt(0)" ::: "memory");
    const int c = lane & 7;
#pragma unroll
    for (int j = 0; j < 4; ++j) { const int n = (lane >> 3) + 8 * j; const LAS float* s = scr + (8 * c) * 33 + n;
        u32x4 o; o.x = cvt_pk(s[0], s[33]); o.y = cvt_pk(s[66], s[99]); o.z = cvt_pk(s[132], s[165]); o.w = cvt_pk(s[198], s[231]);
        const int nn = n0 + n; const int drow = (mode == 0) ? nn : ((nn >> 7) * 256 + (nn & 127) + (mode == 2 ? 128 : 0));
        *(u32x4*)(dst + (size_t)drow * dpitch + k0 + 8 * c) = o; }
    asm volatile("s_waitcnt lgkmcnt(0)" ::: "memory");
}
__device__ __forceinline__ void rownorm1024(const float* src, bf16_t* dst, int lane) {
    const f32x4* s4 = (const f32x4*)src;
    const f32x4 a0 = s4[2 * lane], a1 = s4[2 * lane + 1], b0 = s4[128 + 2 * lane], b1 = s4[129 + 2 * lane];
    const float ss = wave_sum((sq4(a0) + sq4(a1)) + (sq4(b0) + sq4(b1)));
    const float r = 1.0f / sqrtf(ss * (1.f / 1024.f) + EPS);
    *(u32x4*)(dst + 8 * lane) = pack8(a0 * r, a1 * r); *(u32x4*)(dst + 512 + 8 * lane) = pack8(b0 * r, b1 * r);
}

__device__ __forceinline__ void p0_prologue(const Params& p, LAS unsigned char* lds, int G) {
    const int tid = opaque_tid(), lane = tid & 63, wave = tid >> 6;
    unsigned char* ws = p.ws;
    const int gw = blockIdx.x * 8 + wave, NGW = G * 8;
    for (int m = gw; m < M; m += 4 * NGW) {
        f32x4 a0[4], a1[4], b0[4], b1[4];
#pragma unroll
        for (int k = 0; k < 4; ++k) { const int mm = (m + k * NGW < M) ? m + k * NGW : m; const f32x4* s4 = (const f32x4*)(p.in[0] + (size_t)mm * D);
            a0[k] = s4[2 * lane]; a1[k] = s4[2 * lane + 1]; b0[k] = s4[128 + 2 * lane]; b1[k] = s4[129 + 2 * lane]; }
#pragma unroll
        for (int k = 0; k < 4; ++k) { const int mm = m + k * NGW; if (mm < M) {
            const float ss = wave_sum((sq4(a0[k]) + sq4(a1[k])) + (sq4(b0[k]) + sq4(b1[k])));
            const float r = 1.0f / sqrtf(ss * (1.f / 1024.f) + EPS);
            bf16_t* dst = (bf16_t*)(ws + WS_XN) + (size_t)mm * D;
            *(u32x4*)(dst + 8 * lane) = pack8(a0[k] * r, a1[k] * r); *(u32x4*)(dst + 512 + 8 * lane) = pack8(b0[k] * r, b1[k] * r); } }
    }
    LAS float* scr = (LAS float*)lds + wave * (64 * 33);
    constexpr int T_GU = 16 * 88, T_DN = 44 * 32, T_IN = 16 * 45, T_UQ = 4 * 24, T_UKV = 2 * 32, T_OUT = 8 * 32;
    constexpr int NT = 4 * T_GU + 2 * T_DN + T_IN + T_UQ + T_UKV + 2 * T_OUT;
    for (int it = gw; it < NT; it += NGW) {
        int r = it;
        if (r < T_GU) { tr_tile(p.in[3], FF, p.in[2], (bf16_t*)(ws + WS_WGU1), D, 1, r, 88, scr, lane); continue; } r -= T_GU;
        if (r < T_GU) { tr_tile(p.in[4], FF, p.in[2], (bf16_t*)(ws + WS_WGU1), D, 2, r, 88, scr, lane); continue; } r -= T_GU;
        if (r < T_GU) { tr_tile(p.in[21], FF, p.in[20], (bf16_t*)(ws + WS_WGU2), D, 1, r, 88, scr, lane); continue; } r -= T_GU;
        if (r < T_GU) { tr_tile(p.in[22], FF, p.in[20], (bf16_t*)(ws + WS_WGU2), D, 2, r, 88, scr, lane); continue; } r -= T_GU;
        if (r < T_DN) { tr_tile(p.in[5], D, nullptr, (bf16_t*)(ws + WS_WD1), FF, 0, r, 32, scr, lane); continue; } r -= T_DN;
        if (r < T_DN) { tr_tile(p.in[23], D, nullptr, (bf16_t*)(ws + WS_WD2), FF, 0, r, 32, scr, lane); continue; } r -= T_DN;
        if (r < T_IN) { tr_tile(p.in[7], NIN, p.in[6], (bf16_t*)(ws + WS_WIN), D, 0, r, 45, scr, lane); continue; } r -= T_IN;
        if (r < T_UQ) { tr_tile(p.in[12], 768, p.in[11], (bf16_t*)(ws + WS_WUQ), 256, 0, r, 24, scr, lane); continue; } r -= T_UQ;
        if (r < T_UKV) { tr_tile(p.in[14], 1024, p.in[13], (bf16_t*)(ws + WS_WUKV), 128, 0, r, 32, scr, lane); continue; } r -= T_UKV;
        if (r < T_OUT) { tr_tile(p.in[19], D, p.in[17], (bf16_t*)(ws + WS_WOUT), D, 0, r, 32, scr, lane); continue; } r -= T_OUT;
        tr_tile(p.in[19] + (size_t)512 * D, D, p.in[18], (bf16_t*)(ws + WS_WOUT) + 512, D, 0, r, 32, scr, lane);
    }
    const int gt = blockIdx.x * 512 + tid, NGT = G * 512;
    { f32x4* z = (f32x4*)(ws + WS_SS); const f32x4 zero = {0.f, 0.f, 0.f, 0.f};
      for (int i = gt; i < 7 * M / 4; i += NGT) z[i] = zero; }
    { u32x4* z = (u32x4*)((bf16_t*)(ws + WS_WIN) + (size_t)NIN * D); const u32x4 zero = {0u, 0u, 0u, 0u};
      for (int i = gt; i < (NINP - NIN) * D / 8; i += NGT) z[i] = zero; }
    { bf16_t* wsm = (bf16_t*)(ws + WS_WSM);
      for (int i = gt; i < 4 * 128 * 128 / 2; i += NGT) { const int e = 2 * i, ii = (e >> 7) & 127, jj = e & 127;
          const f32x2 v = *(const f32x2*)(p.in[9] + e); const bool keep = (jj >> 6) <= (ii >> 6);
          *(unsigned*)(wsm + e) = keep ? cvt_pk(v.x, v.y) : 0u; } }
    { float* ct = (float*)(ws + WS_COS); float* st = (float*)(ws + WS_SIN); const int* pos = (const int*)p.in[1];
      for (int i = gt; i < M * 16; i += NGT) { const int f = i & 15;
          const float inv = exp2f(-(float)f * (13.287712379549449f / 16.f));
          const float ang = (float)pos[i >> 4] * inv;
          double rev = (double)ang * 0.15915494309189535; rev -= rint(rev);
          const float rr = (float)(rev * 6.283185307179586);
          ct[i] = cosf(rr); st[i] = sinf(rr); } }
}

__device__ __forceinline__ void ynorm_phase(bf16_t* Y, int G) {
    const int tid_ = opaque_tid(), lane = tid_ & 63, gw = blockIdx.x * 8 + (tid_ >> 6), NGW = G * 8;
    for (int m = gw; m < M; m += 4 * NGW) {
        u32x4 a[4], b[4];
#pragma unroll
        for (int k = 0; k < 4; ++k) { const int mm = (m + k * NGW < M) ? m + k * NGW : m; const bf16_t* y = Y + (size_t)mm * 1024;
            a[k] = *(const u32x4*)(y + 8 * lane); b[k] = *(const u32x4*)(y + 512 + 8 * lane); }
#pragma unroll
        for (int k = 0; k < 4; ++k) { const int mm = m + k * NGW; if (mm < M) {
            bf16_t* y = Y + (size_t)mm * 1024;
            const f32x4 a0 = {bflo(a[k].x), bfhi(a[k].x), bflo(a[k].y), bfhi(a[k].y)}, a1 = {bflo(a[k].z), bfhi(a[k].z), bflo(a[k].w), bfhi(a[k].w)};
            const f32x4 b0 = {bflo(b[k].x), bfhi(b[k].x), bflo(b[k].y), bfhi(b[k].y)}, b1 = {bflo(b[k].z), bfhi(b[k].z), bflo(b[k].w), bfhi(b[k].w)};
            const float sa = wave_sum(sq4(a0) + sq4(a1)), sb = wave_sum(sq4(b0) + sq4(b1));
            const float ra = 1.0f / sqrtf(sa * (1.f / 512.f) + EPS), rb = 1.0f / sqrtf(sb * (1.f / 512.f) + EPS);
            *(u32x4*)(y + 8 * lane) = pack8(a0 * ra, a1 * ra); *(u32x4*)(y + 512 + 8 * lane) = pack8(b0 * rb, b1 * rb); } }
    }
}
__device__ __forceinline__ void final_phase(const bf16_t* X, const float* SS, const float* gain, float* out, int G) {
    const int tid_ = opaque_tid(), lane = tid_ & 63, gw = blockIdx.x * 8 + (tid_ >> 6), NGW = G * 8;
    const f32x4* g4 = (const f32x4*)gain;
    const f32x4 ga0 = g4[2 * lane], ga1 = g4[2 * lane + 1], gb0 = g4[128 + 2 * lane], gb1 = g4[129 + 2 * lane];
    for (int m = gw; m < M; m += 4 * NGW) {
        u32x4 a[4], b[4]; float sv[4];
#pragma unroll
        for (int k = 0; k < 4; ++k) { const int mm = (m + k * NGW < M) ? m + k * NGW : m; const bf16_t* x = X + (size_t)mm * D;
            a[k] = *(const u32x4*)(x + 8 * lane); b[k] = *(const u32x4*)(x + 512 + 8 * lane); sv[k] = SS[mm]; }
#pragma unroll
        for (int k = 0; k < 4; ++k) { const int mm = m + k * NGW; if (mm < M) {
            f32x4* o4 = (f32x4*)(out + (size_t)mm * D);
            const float r = 1.0f / sqrtf(sv[k] * (1.f / 1024.f) + EPS);
            const f32x4 a0 = {bflo(a[k].x), bfhi(a[k].x), bflo(a[k].y), bfhi(a[k].y)}, a1 = {bflo(a[k].z), bfhi(a[k].z), bflo(a[k].w), bfhi(a[k].w)};
            const f32x4 b0 = {bflo(b[k].x), bfhi(b[k].x), bflo(b[k].y), bfhi(b[k].y)}, b1 = {bflo(b[k].z), bfhi(b[k].z), bflo(b[k].w), bfhi(b[k].w)};
            o4[2 * lane] = a0 * r * ga0; o4[2 * lane + 1] = a1 * r * ga1; o4[128 + 2 * lane] = b0 * r * gb0; o4[129 + 2 * lane] = b1 * r * gb1; } }
    }
}

constexpr float QSCALE = 0.10206207261596577f * 1.4426950408889634f;
__device__ __forceinline__ void finalize_phase(const Params& p, LAS unsigned char* lds, int G) {
    unsigned char* ws = p.ws;
    const int tid = opaque_tid(), lane = tid & 63, wave = tid >> 6, gw = blockIdx.x * 8 + wave, NGW = G * 8;
    const bf16_t* QRAW = (const bf16_t*)(ws + WS_QRAW); const bf16_t* KVRAW = (const bf16_t*)(ws + WS_KVRAW); const float* KR = (const float*)(ws + WS_KR);
    const float* COS = (const float*)(ws + WS_COS); const float* SIN = (const float*)(ws + WS_SIN);
    bf16_t* KF = (bf16_t*)(ws + WS_KF); bf16_t* VT = (bf16_t*)(ws + WS_VT);
    const int h = lane >> 3, sub = lane & 7;
    const float* gq = p.in[15]; const float* gk = p.in[16];
    const f32x4 gqa = *(const f32x4*)(gq + 8 * sub), gqb = *(const f32x4*)(gq + 8 * sub + 4); const f32x2 gq1 = *(const f32x2*)(gq + 64 + 2 * sub), gq2 = *(const f32x2*)(gq + 80 + 2 * sub);
    const f32x4 gka = *(const f32x4*)(gk + 8 * sub), gkb = *(const f32x4*)(gk + 8 * sub + 4); const f32x2 gk1 = *(const f32x2*)(gk + 64 + 2 * sub), gk2 = *(const f32x2*)(gk + 80 + 2 * sub);
    for (int rowb = gw; rowb < M; rowb += 4 * NGW) {
        u32x4 kn8[4]; f32x2 kx1[4], kx2[4], csv[4], snv[4];
#pragma unroll
        for (int k = 0; k < 4; ++k) {
            const int row = (rowb + k * NGW < M) ? rowb + k * NGW : rowb;
            const bf16_t* kk = KVRAW + (size_t)row * 1024 + h * 128;
            kn8[k] = *(const u32x4*)(kk + 8 * sub);
            kx1[k] = *(const f32x2*)(KR + (size_t)row * 32 + 2 * sub); kx2[k] = *(const f32x2*)(KR + (size_t)row * 32 + 16 + 2 * sub);
            csv[k] = *(const f32x2*)(COS + (size_t)row * 16 + 2 * sub); snv[k] = *(const f32x2*)(SIN + (size_t)row * 16 + 2 * sub);
        }
#pragma unroll
        for (int k = 0; k < 4; ++k) {
            const int row = rowb + k * NGW;
            if (row < M) {
                const int b = row >> 12, s = row & 4095;
                const f32x2 cs = csv[k], sn = snv[k];
                const size_t orow = ((size_t)(b * 8 + h) * SEQ + s) * 96;
                {
                    const u32x4 n8 = kn8[k];
                    f32x4 a0 = {bflo(n8.x), bfhi(n8.x), bflo(n8.y), bfhi(n8.y)}, a1 = {bflo(n8.z), bfhi(n8.z), bflo(n8.w), bfhi(n8.w)};
                    f32x2 x1 = kx1[k], x2 = kx2[k];
                    float ss = sq4(a0) + sq4(a1) + (x1.x * x1.x + x1.y * x1.y) + (x2.x * x2.x + x2.y * x2.y);
                    ss += __shfl_xor(ss, 1); ss += __shfl_xor(ss, 2); ss += __shfl_xor(ss, 4);
                    const float r = 1.0f / sqrtf(ss * (1.f / 96.f) + EPS);
                    a0 = a0 * gka * r; a1 = a1 * gkb * r; x1 = x1 * gk1 * r; x2 = x2 * gk2 * r;
                    const f32x2 o1 = x1 * cs - x2 * sn, o2 = x2 * cs + x1 * sn;
                    *(u32x4*)(KF + orow + 8 * sub) = pack8(a0, a1);
                    *(unsigned*)(KF + orow + 64 + 2 * sub) = cvt_pk(o1.x, o1.y); *(unsigned*)(KF + orow + 80 + 2 * sub) = cvt_pk(o2.x, o2.y);
                }
            }
        }
    }
    LAS bf16_t* buf = (LAS bf16_t*)lds;
    for (int t = blockIdx.x; t < M / 64; t += G) {
        const int row0 = t * 64;
#pragma unroll
        for (int i = 0; i < 8; ++i) { const int pc = tid + 512 * i, tok = pc >> 6, c = pc & 63;
            const u32x4 v = *(const u32x4*)(KVRAW + (size_t)(row0 + tok) * 1024 + (c >> 3) * 128 + 64 + (c & 7) * 8);
            *(LAS u32x4*)(buf + tok * 520 + c * 8) = v; }
        __syncthreads();
        const int b = row0 >> 12, s0 = row0 & 4095;
        bf16_t* dst = VT + ((size_t)(b * 8) * 64 + tid) * SEQ + s0;
#pragma unroll
        for (int i = 0; i < 8; ++i) {
            u32x4 o;
            o.x = (unsigned)buf[(8 * i + 0) * 520 + tid] | ((unsigned)buf[(8 * i + 1) * 520 + tid] << 16);
            o.y = (unsigned)buf[(8 * i + 2) * 520 + tid] | ((unsigned)buf[(8 * i + 3) * 520 + tid] << 16);
            o.z = (unsigned)buf[(8 * i + 4) * 520 + tid] | ((unsigned)buf[(8 * i + 5) * 520 + tid] << 16);
            o.w = (unsigned)buf[(8 * i + 6) * 520 + tid] | ((unsigned)buf[(8 * i + 7) * 520 + tid] << 16);
            *(u32x4*)(dst + 8 * i) = o;
        }
        __syncthreads();
    }
}

__device__ __forceinline__ void gmlp_phase(const Params& p, LAS unsigned char* lds, int G) {
    unsigned char* ws = p.ws;
    const int tid = opaque_tid(), lane = tid & 63, wave = tid >> 6, l32 = lane & 31, hi = lane >> 5, wi = wave >> 1, wc = wave & 1;
    const bf16_t* GU = (const bf16_t*)(ws + WS_GU); const bf16_t* GV = (const bf16_t*)(ws + WS_GV); const bf16_t* WSM = (const bf16_t*)(ws + WS_WSM);
    bf16_t* Y = (bf16_t*)(ws + WS_Y);
    const float* gvn = p.in[8]; const float* bs = p.in[10];
    float* SSA = (float*)(ws + WS_SS) + 5 * M;
    LAS bf16_t* vT = (LAS bf16_t*)lds;
    const int j = tid >> 2, part = tid & 3;
    const int nunits = M / 128;
    if ((int)blockIdx.x >= nunits) return;
    u32x4 v0, v1, v2, v3;
    { const u32x4* src = (const u32x4*)(GV + (size_t)(blockIdx.x * 128 + j) * 512 + part * 32); v0 = src[0]; v1 = src[1]; v2 = src[2]; v3 = src[3]; }
    for (int unit = blockIdx.x; unit < nunits; unit += G) {
        const int row0 = unit * 128;
        for (int g = 0; g < 4; ++g) {
            const int i = 32 * wi + l32; const size_t tok = (size_t)(row0 + i);
            const int cb = g * 128 + 64 * wc + 4 * hi;
            const bf16_t* ap = WSM + (size_t)(g * 128 + i) * 128 + 8 * hi;
            bf16x8 wf[8]; u32x2 guv[8];
#pragma unroll
            for (int ks = 0; ks < 8; ++ks) wf[ks] = *(const bf16x8*)(ap + 16 * ks);
#pragma unroll
            for (int q = 0; q < 4; ++q) { guv[2 * q] = *(const u32x2*)(GU + tok * 512 + cb + 8 * q); guv[2 * q + 1] = *(const u32x2*)(GU + tok * 512 + cb + 32 + 8 * q); }
            const float bi = bs[g * 128 + i];
            {
                float f[32];
                f[0] = bflo(v0.x); f[1] = bfhi(v0.x); f[2] = bflo(v0.y); f[3] = bfhi(v0.y); f[4] = bflo(v0.z); f[5] = bfhi(v0.z); f[6] = bflo(v0.w); f[7] = bfhi(v0.w);
                f[8] = bflo(v1.x); f[9] = bfhi(v1.x); f[10] = bflo(v1.y); f[11] = bfhi(v1.y); f[12] = bflo(v1.z); f[13] = bfhi(v1.z); f[14] = bflo(v1.w); f[15] = bfhi(v1.w);
                f[16] = bflo(v2.x); f[17] = bfhi(v2.x); f[18] = bflo(v2.y); f[19] = bfhi(v2.y); f[20] = bflo(v2.z); f[21] = bfhi(v2.z); f[22] = bflo(v2.w); f[23] = bfhi(v2.w);
                f[24] = bflo(v3.x); f[25] = bfhi(v3.x); f[26] = bflo(v3.y); f[27] = bfhi(v3.y); f[28] = bflo(v3.z); f[29] = bfhi(v3.z); f[30] = bflo(v3.w); f[31] = bfhi(v3.w);
                float ss = 0.f;
#pragma unroll
                for (int e = 0; e < 32; ++e) ss += f[e] * f[e];
                ss += __shfl_xor(ss, 1); ss += __shfl_xor(ss, 2);
                const float r = 1.0f / sqrtf(ss * (1.f / 128.f) + EPS);
#pragma unroll
                for (int e = 0; e < 32; e += 2) { const unsigned w = cvt_pk(f[e] * r, f[e + 1] * r);
                    vT[(part * 32 + e) * 136 + j] = (bf16_t)(w & 0xffffu); vT[(part * 32 + e + 1) * 136 + j] = (bf16_t)(w >> 16); }
            }
            {
                const int gn = (g + 1) & 3, un = (g == 3) ? unit + G : unit;
                if (un < nunits) { const u32x4* src = (const u32x4*)(GV + (size_t)(un * 128 + j) * 512 + gn * 128 + part * 32); v0 = src[0]; v1 = src[1]; v2 = src[2]; v3 = src[3]; }
            }
            __syncthreads();
            f32x16 acc0, acc1;
#pragma unroll
            for (int e = 0; e < 16; ++e) { acc0[e] = 0.f; acc1[e] = 0.f; }
            const LAS bf16_t* bp0 = vT + (64 * wc + l32) * 136 + 8 * hi; const LAS bf16_t* bp1 = bp0 + 32 * 136;
#pragma unroll
            for (int ks = 0; ks < 8; ++ks) {
                const bf16x8 b0 = *(const LAS bf16x8*)(bp0 + 16 * ks), b1 = *(const LAS bf16x8*)(bp1 + 16 * ks);
                acc0 = __builtin_amdgcn_mfma_f32_32x32x16_bf16(b0, wf[ks], acc0, 0, 0, 0);
                acc1 = __builtin_amdgcn_mfma_f32_32x32x16_bf16(b1, wf[ks], acc1, 0, 0, 0);
            }
            float yss = 0.f;
#pragma unroll
            for (int q = 0; q < 4; ++q) {
#pragma unroll
                for (int hb = 0; hb < 2; ++hb) {
                    const int c = cb + 32 * hb + 8 * q;
                    const u32x2 gu = guv[2 * q + hb]; const f32x4 gv = *(const f32x4*)(gvn + c);
                    const float a0 = hb ? acc1[4 * q] : acc0[4 * q], a1 = hb ? acc1[4 * q + 1] : acc0[4 * q + 1], a2 = hb ? acc1[4 * q + 2] : acc0[4 * q + 2], a3 = hb ? acc1[4 * q + 3] : acc0[4 * q + 3];
                    const float y0 = bflo(gu.x) * (gv.x * a0 + bi), y1 = bfhi(gu.x) * (gv.y * a1 + bi), y2 = bflo(gu.y) * (gv.z * a2 + bi), y3 = bfhi(gu.y) * (gv.w * a3 + bi);
                    yss += (y0 * y0 + y1 * y1) + (y2 * y2 + y3 * y3);
                    u32x2 o; o.x = cvt_pk(y0, y1); o.y = cvt_pk(y2, y3);
                    *(u32x2*)(Y + tok * 1024 + c) = o;
                }
            }
            yss += __shfl_xor(yss, 32);
            if (hi == 0) unsafeAtomicAdd(SSA + tok, yss);
            __syncthreads();
        }
    }
}

#define LBAR() do { asm volatile("s_waitcnt lgkmcnt(0)" ::: "memory"); __builtin_amdgcn_s_barrier(); asm volatile("" ::: "memory"); } while (0)
__device__ __forceinline__ float max3f(float a, float b, float c) { float r; asm("v_max3_f32 %0, %1, %2, %3" : "=v"(r) : "v"(a), "v"(b), "v"(c)); return r; }
constexpr int KPITCH = 208, VPITCH = 264, KBUF = 128 * KPITCH, VBUF = 64 * VPITCH, VOFF = 2 * KBUF;
#define ATT_LOAD(ST) do { const int sl_ = (ST); const bf16_t* kb_ = kbase + (size_t)sl_ * 128 * 96; const bf16_t* vb_ = vbase + sl_ * 128; \
    rk0 = *(const u32x4*)(kb_ + (size_t)kr0 * 96 + kc0 * 8); rk1 = *(const u32x4*)(kb_ + (size_t)kr1 * 96 + kc1 * 8); rk2 = *(const u32x4*)(kb_ + (size_t)kr2 * 96 + kc2 * 8); \
    rv0 = *(const u32x4*)(vb_ + (size_t)vr0 * SEQ + vc0 * 8); rv1 = *(const u32x4*)(vb_ + (size_t)(vr0 + 32) * SEQ + vc0 * 8); } while (0)
#define ATT_STORE(B) do { LAS unsigned char* kd_ = lds + (B) * KBUF; LAS unsigned char* vd_ = lds + VOFF + (B) * VBUF + vr0 * VPITCH + vc0 * 16; \
    *(LAS u32x4*)(kd_ + kr0 * KPITCH + kc0 * 16) = rk0; *(LAS u32x4*)(kd_ + kr1 * KPITCH + kc1 * 16) = rk1; *(LAS u32x4*)(kd_ + kr2 * KPITCH + kc2 * 16) = rk2; \
    *(LAS u32x2*)(vd_) = (u32x2){rv0.x, rv0.y}; *(LAS u32x2*)(vd_ + 8) = (u32x2){rv0.z, rv0.w}; \
    *(LAS u32x2*)(vd_ + 32 * VPITCH) = (u32x2){rv1.x, rv1.y}; *(LAS u32x2*)(vd_ + 32 * VPITCH + 8) = (u32x2){rv1.z, rv1.w}; } while (0)
#define ATT_COMPUTE(BUF, J) do { \
    const LAS unsigned char* Kb_ = lds + (BUF) * KBUF + (64 * (J) + l32) * KPITCH + hi * 16; \
    const LAS unsigned char* Vb_ = lds + VOFF + (BUF) * VBUF + l32 * VPITCH + 128 * (J) + hi * 8; \
    bf16x8 kf_[12]; \
    _Pragma("unroll") for (int ks_ = 0; ks_ < 6; ++ks_) { kf_[2 * ks_] = *(const LAS bf16x8*)(Kb_ + ks_ * 32); kf_[2 * ks_ + 1] = *(const LAS bf16x8*)(Kb_ + 32 * KPITCH + ks_ * 32); } \
    __builtin_amdgcn_sched_barrier(0); \
    f32x16 s0 = __builtin_amdgcn_mfma_f32_32x32x16_bf16(kf_[0], qf[0], negv, 0, 0, 0), s1 = __builtin_amdgcn_mfma_f32_32x32x16_bf16(kf_[1], qf[0], negv, 0, 0, 0); \
    _Pragma("unroll") for (int ks_ = 1; ks_ < 6; ++ks_) { \
        s0 = __builtin_amdgcn_mfma_f32_32x32x16_bf16(kf_[2 * ks_], qf[ks_], s0, 0, 0, 0); \
        s1 = __builtin_amdgcn_mfma_f32_32x32x16_bf16(kf_[2 * ks_ + 1], qf[ks_], s1, 0, 0, 0); } \
    __builtin_amdgcn_sched_barrier(0); \
    u32x2 vf_[16]; \
    _Pragma("unroll") for (int k4_ = 0; k4_ < 4; ++k4_) { \
        vf_[4 * k4_] = *(const LAS u32x2*)(Vb_ + k4_ * 32); vf_[4 * k4_ + 1] = *(const LAS u32x2*)(Vb_ + k4_ * 32 + 16); \
        vf_[4 * k4_ + 2] = *(const LAS u32x2*)(Vb_ + 32 * VPITCH + k4_ * 32); vf_[4 * k4_ + 3] = *(const LAS u32x2*)(Vb_ + 32 * VPITCH + k4_ * 32 + 16); } \
    __builtin_amdgcn_sched_barrier(0); \
    _Pragma("unroll") for (int e_ = 0; e_ < 16; ++e_) { s0[e_] = __builtin_amdgcn_exp2f(s0[e_]); s1[e_] = __builtin_amdgcn_exp2f(s1[e_]); } \
    { const f32x16 sm_ = s0 + s1; \
      const float pa_ = (sm_[0] + sm_[1]) + (sm_[2] + sm_[3]), pb2_ = (sm_[4] + sm_[5]) + (sm_[6] + sm_[7]), pc_ = (sm_[8] + sm_[9]) + (sm_[10] + sm_[11]), pd_ = (sm_[12] + sm_[13]) + (sm_[14] + sm_[15]); \
      lsum += (pa_ + pb2_) + (pc_ + pd_); } \
    u32x4 pw_[4]; \
    pw_[0].x = cvt_pk(s0[0], s0[1]); pw_[0].y = cvt_pk(s0[2], s0[3]); pw_[0].z = cvt_pk(s0[4], s0[5]); pw_[0].w = cvt_pk(s0[6], s0[7]); \
    pw_[1].x = cvt_pk(s0[8], s0[9]); pw_[1].y = cvt_pk(s0[10], s0[11]); pw_[1].z = cvt_pk(s0[12], s0[13]); pw_[1].w = cvt_pk(s0[14], s0[15]); \
    pw_[2].x = cvt_pk(s1[0], s1[1]); pw_[2].y = cvt_pk(s1[2], s1[3]); pw_[2].z = cvt_pk(s1[4], s1[5]); pw_[2].w = cvt_pk(s1[6], s1[7]); \
    pw_[3].x = cvt_pk(s1[8], s1[9]); pw_[3].y = cvt_pk(s1[10], s1[11]); pw_[3].z = cvt_pk(s1[12], s1[13]); pw_[3].w = cvt_pk(s1[14], s1[15]); \
    __builtin_amdgcn_sched_barrier(0); \
    _Pragma("unroll") for (int k4_ = 0; k4_ < 4; ++k4_) { \
        const bf16x8 pb_ = __builtin_bit_cast(bf16x8, pw_[k4_]); \
        const u32x4 va_ = {vf_[4 * k4_].x, vf_[4 * k4_].y, vf_[4 * k4_ + 1].x, vf_[4 * k4_ + 1].y}, vb_ = {vf_[4 * k4_ + 2].x, vf_[4 * k4_ + 2].y, vf_[4 * k4_ + 3].x, vf_[4 * k4_ + 3].y}; \
        o0 = __builtin_amdgcn_mfma_f32_32x32x16_bf16(__builtin_bit_cast(bf16x8, va_), pb_, o0, 0, 0, 0); \
        o1 = __builtin_amdgcn_mfma_f32_32x32x16_bf16(__builtin_bit_cast(bf16x8, vb_), pb_, o1, 0, 0, 0); } } while (0)

__device__ __forceinline__ void attn_phase(const Params& p, LAS unsigned char* lds, int G) {
    unsigned char* ws = p.ws;
    const int tid = opaque_tid(), lane = tid & 63, wave = __builtin_amdgcn_readfirstlane(tid >> 6), l32 = lane & 31, hi = lane >> 5;
    const bf16_t* QRAW = (const bf16_t*)(ws + WS_QRAW); const bf16_t* KF = (const bf16_t*)(ws + WS_KF); const bf16_t* VT = (const bf16_t*)(ws + WS_VT);
    const float* COS = (const float*)(ws + WS_COS); const float* SIN = (const float*)(ws + WS_SIN);
    bf16_t* Y = (bf16_t*)(ws + WS_Y);
    const int kr0 = tid / 12, kc0 = tid - kr0 * 12;
    const int kr1 = (tid + 512) / 12, kc1 = (tid + 512) - kr1 * 12;
    const int kr2 = (tid + 1024) / 12, kc2 = (tid + 1024) - kr2 * 12;
    const int vr0 = tid >> 4, vc0 = tid & 15;
    float negsb;
    {
        float gq = fmaxf(fabsf(p.in[15][lane]), fabsf(p.in[15][64 + l32])), gk = fmaxf(fabsf(p.in[16][lane]), fabsf(p.in[16][64 + l32]));
#pragma unroll
        for (int o = 1; o < 64; o <<= 1) { gq = fmaxf(gq, __shfl_xor(gq, o)); gk = fmaxf(gk, __shfl_xor(gk, o)); }
        negsb = -(96.f * gq * gk * QSCALE);
    }
    f32x16 negv;
#pragma unroll
    for (int e = 0; e < 16; ++e) negv[e] = negsb;
    asm volatile("" : "+v"(negv));
    for (int it = blockIdx.x; it < 2048; it += G) {
        const int kk = it >> 8, cc = it & 255, bh = cc >> 1, set = cc & 1;
        const int qt = set ? (14 - 2 * kk + (kk & 1)) : (15 - 2 * kk - (kk & 1));
        const int q0 = qt * 256 + 32 * wave, lim = q0 >> 6, nkt = 4 * qt + 4;
        const bf16_t* kbase = KF + (size_t)bh * SEQ * 96; const bf16_t* vbase = VT + (size_t)bh * 64 * SEQ;
        u32x4 rk0, rk1, rk2, rv0, rv1;
        ATT_LOAD(0);
        bf16x8 qf[6];
        {
            const size_t qrow = (size_t)(bh >> 3) * SEQ + q0 + l32;
            const bf16_t* qp = QRAW + qrow * 768 + (bh & 7) * 96 + 8 * hi;
            u32x4 qr[6];
#pragma unroll
            for (int ks = 0; ks < 6; ++ks) qr[ks] = *(const u32x4*)(qp + 16 * ks);
            const f32x4 c0 = *(const f32x4*)(COS + qrow * 16 + 8 * hi), c1 = *(const f32x4*)(COS + qrow * 16 + 8 * hi + 4);
            const f32x4 n0 = *(const f32x4*)(SIN + qrow * 16 + 8 * hi), n1 = *(const f32x4*)(SIN + qrow * 16 + 8 * hi + 4);
            f32x4 xa[6], xb[6]; float ss = 0.f;
#pragma unroll
            for (int ks = 0; ks < 6; ++ks) { xa[ks] = (f32x4){bflo(qr[ks].x), bfhi(qr[ks].x), bflo(qr[ks].y), bfhi(qr[ks].y)}; xb[ks] = (f32x4){bflo(qr[ks].z), bfhi(qr[ks].z), bflo(qr[ks].w), bfhi(qr[ks].w)};
                ss += sq4(xa[ks]) + sq4(xb[ks]); }
            ss += __shfl_xor(ss, 32);
            const float r = QSCALE / sqrtf(ss * (1.f / 96.f) + EPS);
#pragma unroll
            for (int ks = 0; ks < 6; ++ks) { const f32x4 ga = *(const f32x4*)(p.in[15] + 16 * ks + 8 * hi), gb = *(const f32x4*)(p.in[15] + 16 * ks + 8 * hi + 4);
                xa[ks] = xa[ks] * ga * r; xb[ks] = xb[ks] * gb * r; }
            const f32x4 ra = xa[4] * c0 - xa[5] * n0, rb = xb[4] * c1 - xb[5] * n1, rc = xa[5] * c0 + xa[4] * n0, rd = xb[5] * c1 + xb[4] * n1;
            xa[4] = ra; xb[4] = rb; xa[5] = rc; xb[5] = rd;
#pragma unroll
            for (int ks = 0; ks < 6; ++ks) qf[ks] = __builtin_bit_cast(bf16x8, pack8(xa[ks], xb[ks]));
        }
        f32x16 o0, o1;
#pragma unroll
        for (int e = 0; e < 16; ++e) { o0[e] = 0.f; o1[e] = 0.f; }
        float lsum = 0.f;
        const int nst = nkt >> 1;
        ATT_STORE(0);
        LBAR();
        for (int st = 0; st < nst; ++st) {
            const int buf = st & 1; const bool more = (st + 1 < nst);
            if (more) ATT_LOAD(st + 1);
            if (2 * st <= lim) ATT_COMPUTE(buf, 0);
            if (2 * st + 1 <= lim) ATT_COMPUTE(buf, 1);
            if (more) ATT_STORE(buf ^ 1);
            LBAR();
        }
        lsum += __shfl_xor(lsum, 32);
        const float inv = 1.0f / lsum;
        const int b = bh >> 3, h = bh & 7;
        {
            const f32x16 q0v = o0 * inv, q1v = o1 * inv; float yss = 0.f;
#pragma unroll
            for (int e = 0; e < 16; ++e) yss += q0v[e] * q0v[e] + q1v[e] * q1v[e];
            yss += __shfl_xor(yss, 32);
            if (hi == 0) unsafeAtomicAdd((float*)(ws + WS_SS) + 6 * M + (size_t)b * SEQ + q0 + l32, yss);
        }
        bf16_t* yp = Y + ((size_t)b * SEQ + q0 + l32) * 1024 + 512 + h * 64 + 4 * hi;
#pragma unroll
        for (int j4 = 0; j4 < 4; ++j4) {
            u32x2 w0, w1;
            w0.x = cvt_pk(o0[4 * j4] * inv, o0[4 * j4 + 1] * inv); w0.y = cvt_pk(o0[4 * j4 + 2] * inv, o0[4 * j4 + 3] * inv);
            w1.x = cvt_pk(o1[4 * j4] * inv, o1[4 * j4 + 1] * inv); w1.y = cvt_pk(o1[4 * j4 + 2] * inv, o1[4 * j4 + 3] * inv);
            *(u32x2*)(yp + 8 * j4) = w0; *(u32x2*)(yp + 32 + 8 * j4) = w1;
        }
    }
}


#define XB_TMO      128
#define XB_XCNT(j)  (256  + 64 * (j))
#define XB_XSUB(j)  (1280 + 64 * (j))
#define XB_XGEN(j)  (2304 + 64 * (j))
#define XB_TOP      3328
#define XB_TOPGEN   3392
#define XCD_BAR_WORDS 3456
#define XB_SPIN_CAP (1u << 18)

__device__ __forceinline__ unsigned xb_ld(unsigned* p)              { return __hip_atomic_load(p, __ATOMIC_RELAXED, __HIP_MEMORY_SCOPE_AGENT); }
__device__ __forceinline__ unsigned xb_add(unsigned* p, unsigned v) { return __hip_atomic_fetch_add(p, v, __ATOMIC_RELAXED, __HIP_MEMORY_SCOPE_AGENT); }
__device__ __forceinline__ unsigned xb_xcc_id() { return (unsigned)__builtin_amdgcn_s_getreg((3 << 11) | 20) & 0xFu; }
#define XB_SPIN(cond, bar) do { unsigned _sp = 0; while (cond) { __builtin_amdgcn_s_sleep(1); \
    if ((++_sp & 255u) == 0u) { if (xb_ld(&(bar)[XB_TMO])) break; if (_sp > XB_SPIN_CAP) { atomicAdd(&(bar)[XB_TMO], 1u); break; } } } } while (0)

struct XcdBarrier {
    unsigned* bar; unsigned x;
    volatile LAS unsigned* st;
};

__device__ __forceinline__ XcdBarrier xcd_barrier_post(unsigned* bar, volatile LAS unsigned* st) {
    XcdBarrier b; b.bar = bar; b.x = xb_xcc_id(); b.st = st;
    if (threadIdx.x == 0) (void)xb_add(&bar[XB_XCNT(b.x)], 1u);
    return b;
}
__device__ __forceinline__ void xcd_barrier_complete(unsigned* bar, unsigned x, unsigned& nloc, unsigned& nx) {
    const unsigned G = gridDim.x * gridDim.y * gridDim.z;
    unsigned sum, cnt, mine, sp = 0u;
    for (;;) {
        sum = 0u; cnt = 0u; mine = 0u;
#pragma unroll
        for (unsigned j = 0; j < 16; ++j) { const unsigned c = xb_ld(&bar[XB_XCNT(j)]); sum += c; cnt += (c > 0u) ? 1u : 0u; mine = (j == x) ? c : mine; }
        if (sum == G) break;
        __builtin_amdgcn_s_sleep(1);
        if ((++sp & 255u) == 0u) { if (xb_ld(&bar[XB_TMO])) break; if (sp > XB_SPIN_CAP) { atomicAdd(&bar[XB_TMO], 1u); break; } }
    }
    nloc = mine > 0u ? mine : 1u; nx = cnt > 0u ? cnt : 1u;
}

__device__ __forceinline__ void xcd_barrier(const XcdBarrier& b) {
    asm volatile("s_waitcnt vmcnt(0)" ::: "memory");
    __syncthreads();
    if (threadIdx.x == 0) {
        unsigned* bar = b.bar;
        __builtin_amdgcn_s_waitcnt(0);
        unsigned nloc = b.st[0], nx = b.st[1];
        if (nloc == 0u) { xcd_barrier_complete(bar, b.x, nloc, nx); b.st[0] = nloc; b.st[1] = nx; }
        const unsigned old = xb_add(&bar[XB_XSUB(b.x)], 1u);
        const unsigned gen = old / nloc;
        if (old + 1u == (gen + 1u) * nloc) {
            __builtin_amdgcn_fence(__ATOMIC_RELEASE, "agent");
            asm volatile("s_waitcnt vmcnt(0)" ::: "memory");
            const unsigned og = xb_add(&bar[XB_TOP], 1u);
            const unsigned tg = og / nx;
            if (og + 1u == (tg + 1u) * nx) xb_add(&bar[XB_TOPGEN], 1u);
            else XB_SPIN(xb_ld(&bar[XB_TOPGEN]) == tg, bar);
            __builtin_amdgcn_fence(__ATOMIC_ACQUIRE, "agent");
            xb_add(&bar[XB_XGEN(b.x)], 1u);
            asm volatile("s_waitcnt vmcnt(0)" ::: "memory");
        } else {
            XB_SPIN(xb_ld(&bar[XB_XGEN(b.x)]) == gen, bar);
            __builtin_amdgcn_fence(__ATOMIC_ACQUIRE, "agent");
            asm volatile("s_waitcnt vmcnt(0)" ::: "memory");
        }
    }
    __syncthreads();
}


__device__ __forceinline__ void grid_bar(unsigned* ctr, unsigned target) {
    asm volatile("s_waitcnt vmcnt(0) lgkmcnt(0)" ::: "memory");
    __syncthreads();
    if (threadIdx.x == 0) {
        __builtin_amdgcn_fence(__ATOMIC_RELEASE, "agent");
        __hip_atomic_fetch_add(ctr, 1u, __ATOMIC_RELAXED, __HIP_MEMORY_SCOPE_AGENT);
        unsigned spins = 0;
        while (__hip_atomic_load(ctr, __ATOMIC_RELAXED, __HIP_MEMORY_SCOPE_AGENT) < target && ++spins < (1u << 24)) __builtin_amdgcn_s_sleep(2);
    }
    __syncthreads();
    __builtin_amdgcn_fence(__ATOMIC_ACQUIRE, "agent");
}

constexpr int NPH = 12;
constexpr int NCH = 1, MCH = M / NCH;
#define REPMASK 0x0
#define RP(k) for (int rep = 0; rep < 1 + ((REPMASK >> (k)) & 1); ++rep)
#define RS do { if (rep) cg::this_grid().sync(); } while (0)
__global__ void __launch_bounds__(512, 2) mk_fwd(Params p) {
    extern __shared__ __attribute__((aligned(16))) unsigned char smem[];
    LAS unsigned char* lds = (LAS unsigned char*)smem;
    const int G = gridDim.x;
    unsigned char* ws = p.ws;
    const int lo = p.ph_lo, hi = p.ph_hi;
#define IN(k) (lo <= (k) && (k) < hi)
#define SEAM(k) do { if (IN(k) && IN((k) + 1)) xcd_barrier(xbar); } while (0)
    bf16_t* XN = (bf16_t*)(ws + WS_XN); bf16_t* HID = (bf16_t*)(ws + WS_HID); bf16_t* Y = (bf16_t*)(ws + WS_Y);
    volatile LAS unsigned* xst = (volatile LAS unsigned*)(lds + 131072);
    if (threadIdx.x == 0) { xst[0] = 0u; xst[1] = 0u; }
    __syncthreads();
    const XcdBarrier xbar = xcd_barrier_post((unsigned*)(ws + WS_BAR), xst);
    float* SS1 = (float*)(ws + WS_SS); float* SS2 = SS1 + M; float* SS3 = SS2 + M; float* SSQ = SS3 + M; float* SSKV = SSQ + M;

    if (lo < 0) cg::this_grid().sync();
    if (IN(0)) RP(0) { RS; p0_prologue(p, lds, G); } SEAM(0);
    for (int ch = 0; ch < NCH; ++ch) {
        const size_t r0 = (size_t)ch * MCH;
        if (IN(1)) {
            pg8::Gemm g{XN + r0 * D, (const bf16_t*)(ws + WS_WGU1), MCH, NGU, D}; pg8::StaticOrder S; S.init(MCH, NGU, G, (int)blockIdx.x);
            EpiSwiglu<false> E{HID + r0 * FF, nullptr}; pg8::gemm_phase<EpiSwiglu<false>, pg8::StaticOrder, true, true>(lds, g, S, E);
        }
        if (IN(1) && IN(2)) xcd_barrier(xbar);
        if (IN(2)) {
            pg8::Gemm g{HID + r0 * FF, (const bf16_t*)(ws + WS_WD1), MCH, D, FF}; pg8::StaticOrder S; S.init(MCH, D, G, (int)blockIdx.x);
            EpiResid<true> E{p.in[0] + r0 * D, XN + r0 * D, SS1 + r0, 0.5f}; pg8::gemm_phase<EpiResid<true>, pg8::StaticOrder, true, true, true>(lds, g, S, E);
        }
        if (IN(1) && IN(2)) xcd_barrier(xbar);
    }
    if (IN(3)) {
        pg8::Gemm g{XN, (const bf16_t*)(ws + WS_WIN), M, NINP, D}; pg8::StaticOrder S; S.init(M, NINP, G, (int)blockIdx.x);
        EpiH E{(bf16_t*)(ws + WS_GU), (bf16_t*)(ws + WS_GV), (bf16_t*)(ws + WS_CQN), (bf16_t*)(ws + WS_CKVN), (float*)(ws + WS_KR), SS1, SSQ, SSKV};
        pg8::gemm_phase<EpiH, pg8::StaticOrder, true, true>(lds, g, S, E);
    } SEAM(3);
    if (IN(4)) RP(4) { RS;
        { pg8::Gemm g{(const bf16_t*)(ws + WS_CQN), (const bf16_t*)(ws + WS_WUQ), M, 768, 256}; pg8::StaticOrder S; S.init(M, 768, G, (int)blockIdx.x);
          EpiPlain E{(bf16_t*)(ws + WS_QRAW), 768, SSQ, 1.f / 256.f}; pg8::gemm_phase<EpiPlain, pg8::StaticOrder, true, true>(lds, g, S, E); }
        { pg8::Gemm g{(const bf16_t*)(ws + WS_CKVN), (const bf16_t*)(ws + WS_WUKV), M, 1024, 128}; pg8::StaticOrder S; S.init(M, 1024, G, (int)blockIdx.x);
          EpiPlain E{(bf16_t*)(ws + WS_KVRAW), 1024, SSKV, 1.f / 128.f}; pg8::gemm_phase<EpiPlain, pg8::StaticOrder, true, true>(lds, g, S, E); }
    } SEAM(4);
    if (IN(5)) RP(5) { RS; finalize_phase(p, lds, G); } SEAM(5);
    if (IN(6)) RP(6) { RS; attn_phase(p, lds, G); gmlp_phase(p, lds, G); } SEAM(6);
    if (IN(8)) {
        pg8::Gemm g{Y, (const bf16_t*)(ws + WS_WOUT), M, D, D}; OrderY S; S.init(M, D, G, (int)blockIdx.x); S.SSA = SS1 + 5 * M; S.SSB = SS1 + 6 * M; S.F = (LAS float*)(lds + 131072 + 64);
        EpiResidY E{XN, SS2, SS1 + 6 * M, (const LAS float*)(lds + 131072 + 64)}; pg8::gemm_phase<EpiResidY, OrderY, true, true>(lds, g, S, E);
    } SEAM(8);
    for (int ch = 0; ch < NCH; ++ch) {
        const size_t r0 = (size_t)ch * MCH;
        if (IN(9)) {
            pg8::Gemm g{XN + r0 * D, (const bf16_t*)(ws + WS_WGU2), MCH, NGU, D}; pg8::StaticOrder S; S.init(MCH, NGU, G, (int)blockIdx.x);
            EpiSwiglu<true> E{HID + r0 * FF, SS2 + r0}; pg8::gemm_phase<EpiSwiglu<true>, pg8::StaticOrder, true, true>(lds, g, S, E);
        }
        if (IN(9) && IN(10)) xcd_barrier(xbar);
        if (IN(10)) {
            pg8::Gemm g{HID + r0 * FF, (const bf16_t*)(ws + WS_WD2), MCH, D, FF}; pg8::StaticOrder S; S.init(MCH, D, G, (int)blockIdx.x);
            EpiResid<false> E{nullptr, XN + r0 * D, SS3 + r0, 0.5f}; pg8::gemm_phase<EpiResid<false>, pg8::StaticOrder, true, true, true>(lds, g, S, E);
        }
        if (IN(9) && IN(10)) xcd_barrier(xbar);
    }
    if (IN(11)) { final_phase(XN, SS3, p.in[24], p.out, G); }
#undef IN
#undef SEAM
}

extern "C" void kernel_launch(void* const* d_in, const int* in_sizes, int n_in, void* d_out, int out_size, void* d_ws, size_t ws_size, hipStream_t stream) {
    static int grid = 0;
    if (grid == 0) {
        if (n_in != 25 || out_size != M * D || ws_size < WS_END) { fprintf(stderr, "kernel_launch: unexpected shapes: n_in %d out %d ws %zu\n", n_in, out_size, ws_size); grid = -1; return; }
        int dev = 0, cus = 0, per_cu = 0;
        (void)hipGetDevice(&dev); (void)hipDeviceGetAttribute(&cus, hipDeviceAttributeMultiprocessorCount, dev);
        if (hipFuncSetAttribute((const void*)mk_fwd, hipFuncAttributeMaxDynamicSharedMemorySize, LDS_BYTES) != hipSuccess) { fprintf(stderr, "kernel_launch: hipFuncSetAttribute failed\n"); grid = -1; return; }
        if (hipOccupancyMaxActiveBlocksPerMultiprocessor(&per_cu, (const void*)mk_fwd, 512, LDS_BYTES) != hipSuccess || per_cu < 1) { fprintf(stderr, "kernel_launch: occupancy query says %d\n", per_cu); per_cu = 1; }
        (void)hipGetLastError();
        grid = cus * per_cu;
        fprintf(stderr, "kernel_launch: grid %d (%d CUs x %d)\n", grid, cus, per_cu);
    }
    if (grid < 0) return;
    Params p{};
    for (int i = 0; i < 25; ++i) p.in[i] = (const float*)d_in[i];
    p.out = (float*)d_out; p.ws = (unsigned char*)d_ws;
#if MK_COOP
    (void)hipMemsetAsync((unsigned char*)d_ws + WS_BAR, 0, 16384, stream);
    p.ph_lo = 0; p.ph_hi = NPH;
    void* args[] = {&p};
    hipError_t e = hipLaunchCooperativeKernel((const void*)mk_fwd, dim3(grid), dim3(512), args, LDS_BYTES, stream);
    if (e != hipSuccess) fprintf(stderr, "kernel_launch: cooperative launch failed: %s (grid %d)\n", hipGetErrorString(e), grid);
#else
    for (int ph = 0; ph < NPH; ++ph) {
        p.ph_lo = ph; p.ph_hi = ph + 1;
        hipLaunchKernelGGL(mk_fwd, dim3(grid), dim3(512), LDS_BYTES, stream, p);
    }
#endif
}
```

```cpp
#include <hip/hip_runtime.h>
#include <hip/hip_cooperative_groups.h>
#include <cstdio>
#include <cstdint>
namespace cg = cooperative_groups;
#ifndef MK_COOP
#define MK_COOP 1
#endif
__device__ __forceinline__ int opaque_tid() { int t = threadIdx.x; asm volatile("" : "+v"(t)); return t; }
namespace pg8 {
#define PG8_LAS __attribute__((address_space(3)))
typedef unsigned short bf16_t;
typedef short bf16x8 __attribute__((ext_vector_type(8)));
typedef float f32x4 __attribute__((ext_vector_type(4)));
typedef unsigned u32x4 __attribute__((ext_vector_type(4)));
constexpr int BM = 256, BK = 64, HALF = 128, HTB = HALF * BK * 2  , STAGE_BYTES = 8 * HTB, NXCD = 8, WGM = 4;

__host__ __device__ __forceinline__ int lds_byte(int r, int c) { const int st = (r >> 4) * 2 + (c >> 5), rr = r & 15, cc = c & 31, ob = rr * 64 + cc * 2; return st * 1024 + (ob ^ (((ob >> 9) & 1) << 5)); }
__host__ __device__ __forceinline__ void stage_rc(int b, int& R, int& C) { const int st = b / 1024, sb = b % 1024, swz = sb ^ (((sb >> 9) & 1) << 5); R = (st >> 1) * 16 + swz / 64; C = (st & 1) * 32 + (swz % 64) / 2; }
__host__ __device__ __forceinline__ int perm32(int rho) { const int n = rho >> 4, i = rho & 15; return 8 * (i >> 2) + 4 * n + (i & 3); }

struct Unit { int pm, pn; };
struct Gemm { const bf16_t* A; const bf16_t* Bt; int M, N, K; };

struct StaticOrder {
    int nM, nN, nwg, G, c;
    __host__ __device__ void init(int M, int N, int G_, int c_) { nM = M / BM; nN = N / BM; nwg = nM * nN; G = G_; c = c_; }
    __host__ __device__ bool next(int i, Unit& u) const {
        const long L = (long)i * G + c; if (L >= nwg) return false;
        int wgid = (int)L; { const int q = nwg / NXCD, r = nwg % NXCD, xcd = wgid % NXCD, off = wgid / NXCD; wgid = (xcd < r ? xcd * (q + 1) : r * (q + 1) + (xcd - r) * q) + off; }
        const int nig = WGM * nN, gid = wgid / nig, fm = gid * WGM, gsz = (nM - fm) < WGM ? (nM - fm) : WGM;
        u.pm = fm + ((wgid % nig) % gsz); u.pn = (wgid % nig) / gsz; return true;
    }
    __device__ __forceinline__ void a_ready(const Unit&) const {}
    __device__ __forceinline__ void done(const Unit&) const {}
};

__device__ __forceinline__ unsigned cvt_pk_bf16(float lo, float hi) { unsigned r; asm volatile("v_cvt_pk_bf16_f32 %0, %1, %2" : "=v"(r) : "v"(lo), "v"(hi)); return r; }
template <class Epi, class Sched, bool ALIGN_EPI = false, bool SP2 = false, bool ABLK = false>
__device__ __forceinline__ void gemm_phase(PG8_LAS unsigned char* lds, const Gemm g, const Sched& S, const Epi& E) {
    const int tid = ::opaque_tid(), wid = __builtin_amdgcn_readfirstlane(tid >> 6), lane = tid & 63, wr = wid >> 2, wc = wid & 3, fr = lane & 15, fq = lane >> 4;
    const int K = g.K, nt = K / BK;
    unsigned voffA[2], voffB[2];
#pragma unroll
    for (int i = 0; i < 2; ++i) { int R, C; stage_rc(tid * 16 + i * 8192, R, C); const int Rb = Epi::PERM ? ((R & ~31) + perm32(R & 31)) : R;
        voffA[i] = ABLK ? (unsigned)(R * BK + C) * 2u : (unsigned)(R * K + C) * 2u; voffB[i] = (unsigned)(Rb * K + C) * 2u; }
    const size_t kstep = (size_t)(BK * 2);
    const size_t hstep = (size_t)HALF * K * 2;
    const size_t tstep = 2 * hstep;
    const size_t kstepA = ABLK ? (size_t)(BM * BK * 2) : kstep, hstepA = ABLK ? (size_t)(HALF * BK * 2) : hstep;
    const unsigned ldsw = (unsigned)wid * 1024u;
    const int aoff = lds_byte(wr * 64 + fr, fq * 8), boff = lds_byte(wc * 32 + fr, fq * 8);
#define PG8_SA(b, h) (((b) * 2 + (h)) * HTB)
#define PG8_SB(b, h) ((4 + (b) * 2 + (h)) * HTB)
#define PG8_STAGE(bufoff, gbase, voff) do { _Pragma("unroll") for (int _i = 0; _i < 2; ++_i) \
        __builtin_amdgcn_global_load_lds((const unsigned*)((const char*)(gbase) + (voff)[_i]), (PG8_LAS unsigned*)(lds + (bufoff) + ldsw + _i * 8192), 16, 0, 0); } while (0)
#define PG8_LDA(dst, b, h) do { _Pragma("unroll") for (int m = 0; m < 4; ++m) _Pragma("unroll") for (int k = 0; k < 2; ++k) dst[m][k] = *(const PG8_LAS bf16x8*)(lds + PG8_SA(b, h) + aoff + m * 2048 + k * 1024); } while (0)
#define PG8_LDB(dst, b, h) do { _Pragma("unroll") for (int n = 0; n < 2; ++n) _Pragma("unroll") for (int k = 0; k < 2; ++k) dst[n][k] = *(const PG8_LAS bf16x8*)(lds + PG8_SB(b, h) + boff + n * 2048 + k * 1024); } while (0)
#define PG8_MMA(ai, bj, At, Bt) do { __builtin_amdgcn_s_setprio(1); _Pragma("unroll") for (int m = 0; m < 4; ++m) _Pragma("unroll") for (int n = 0; n < 2; ++n) _Pragma("unroll") for (int k = 0; k < 2; ++k) \
        acc[ai][bj][m][n] = __builtin_amdgcn_mfma_f32_16x16x32_bf16(Bt[n][k], At[m][k], acc[ai][bj][m][n], 0, 0, 0); __builtin_amdgcn_s_setprio(0); } while (0)
#define PG8_WAIT_V(n) asm volatile("s_waitcnt vmcnt(" #n ")" ::: "memory")
#define PG8_WAIT_L(n) asm volatile("s_waitcnt lgkmcnt(" #n ")" ::: "memory")
#define PG8_BAR __builtin_amdgcn_s_barrier()
#define PG8_SCHED __builtin_amdgcn_sched_barrier(0)
    Unit cur, nxt; int ui = 0;
    if (!S.next(0, cur)) return;
    f32x4 acc[2][2][4][2];
#pragma unroll
    for (int a = 0; a < 2; ++a)
#pragma unroll
        for (int b = 0; b < 2; ++b)
#pragma unroll
            for (int m = 0; m < 4; ++m)
#pragma unroll
                for (int n = 0; n < 2; ++n) acc[a][b][m][n] = (f32x4){0.f, 0.f, 0.f, 0.f};
    bf16x8 At[4][2], B0[2][2], B1[2][2];
    const char* cA = (const char*)g.A + (size_t)cur.pm * tstep; const char* cB = (const char*)g.Bt + (size_t)cur.pn * tstep;
    S.a_ready(cur);
    if constexpr (SP2) {
        PG8_STAGE(PG8_SB(0, 0), cB, voffB); PG8_STAGE(PG8_SB(0, 1), cB + hstep, voffB); PG8_STAGE(PG8_SA(0, 0), cA, voffA); PG8_STAGE(PG8_SA(0, 1), cA + hstepA, voffA);
        if (wr == 1) PG8_BAR;
        PG8_WAIT_V(2); PG8_BAR;
        PG8_STAGE(PG8_SB(1, 0), cB + kstep, voffB); PG8_STAGE(PG8_SA(1, 0), cA + kstepA, voffA); PG8_STAGE(PG8_SB(1, 1), cB + hstep + kstep, voffB);
        PG8_WAIT_V(6); PG8_BAR;
    } else {
        PG8_STAGE(PG8_SB(0, 0), cB, voffB); PG8_STAGE(PG8_SA(0, 0), cA, voffA); PG8_STAGE(PG8_SB(0, 1), cB + hstep, voffB); PG8_STAGE(PG8_SA(0, 1), cA + hstepA, voffA);
        if (wr == 1) PG8_BAR;
        PG8_WAIT_V(4); PG8_BAR;
        PG8_STAGE(PG8_SB(1, 0), cB + kstep, voffB); PG8_STAGE(PG8_SA(1, 0), cA + kstepA, voffA); PG8_STAGE(PG8_SB(1, 1), cB + hstep + kstep, voffB);
        PG8_WAIT_V(6); PG8_BAR;
    }
    for (;;) {
        const bool has_next = S.next(ui + 1, nxt);
        const char* nA = has_next ? (const char*)g.A + (size_t)nxt.pm * tstep : cA; const char* nB = has_next ? (const char*)g.Bt + (size_t)nxt.pn * tstep : cB;
        for (int t = 0; t < nt; t += 2) {
            const bool last = (t == nt - 2);
            const char* a1 = cA + (size_t)(t + 1) * kstepA;
            const char* a2 = last ? nA : cA + (size_t)(t + 2) * kstepA; const char* b2 = last ? nB : cB + (size_t)(t + 2) * kstep;
            const char* a3 = a2 + kstepA; const char* b3 = b2 + kstep;
            if (last && has_next) S.a_ready(nxt);
            if constexpr (SP2) {
            PG8_LDB(B0, 0, 0); PG8_LDB(B1, 0, 1); PG8_SCHED; PG8_LDA(At, 0, 0); PG8_STAGE(PG8_SA(1, 1), a1 + hstepA, voffA);
            PG8_WAIT_V(8); PG8_WAIT_L(0); PG8_BAR; PG8_MMA(0, 0, At, B0); PG8_MMA(0, 1, At, B1); PG8_BAR; PG8_SCHED;
            PG8_LDA(At, 0, 1); PG8_STAGE(PG8_SB(0, 0), b2, voffB); PG8_STAGE(PG8_SB(0, 1), b2 + hstep, voffB); PG8_STAGE(PG8_SA(0, 0), a2, voffA);
            PG8_WAIT_V(8); PG8_WAIT_L(0); PG8_BAR; PG8_MMA(1, 0, At, B0); PG8_MMA(1, 1, At, B1); PG8_BAR; PG8_SCHED;
            PG8_LDB(B0, 1, 0); PG8_LDB(B1, 1, 1); PG8_SCHED; PG8_LDA(At, 1, 0); PG8_STAGE(PG8_SA(0, 1), a2 + hstepA, voffA);
            PG8_WAIT_V(8); PG8_WAIT_L(0); PG8_BAR; PG8_MMA(0, 0, At, B0); PG8_MMA(0, 1, At, B1); PG8_BAR; PG8_SCHED;
            PG8_LDA(At, 1, 1); PG8_STAGE(PG8_SB(1, 0), b3, voffB); PG8_STAGE(PG8_SB(1, 1), b3 + hstep, voffB); PG8_STAGE(PG8_SA(1, 0), a3, voffA);
            PG8_WAIT_V(8); PG8_WAIT_L(0); PG8_BAR; PG8_MMA(1, 0, At, B0); PG8_MMA(1, 1, At, B1); PG8_BAR; PG8_SCHED;
            } else {
            PG8_LDB(B0, 0, 0); PG8_SCHED; PG8_LDA(At, 0, 0); PG8_STAGE(PG8_SA(1, 1), a1 + hstepA, voffA);
            PG8_WAIT_L(8); PG8_BAR; PG8_WAIT_L(0); PG8_MMA(0, 0, At, B0); PG8_BAR; PG8_SCHED;
            PG8_LDB(B1, 0, 1); PG8_STAGE(PG8_SB(0, 0), b2, voffB);
            PG8_BAR; PG8_WAIT_L(0); PG8_MMA(0, 1, At, B1); PG8_BAR;
            PG8_LDA(At, 0, 1); PG8_STAGE(PG8_SA(0, 0), a2, voffA);
            PG8_BAR; PG8_WAIT_L(0); PG8_MMA(1, 0, At, B0); PG8_BAR; PG8_SCHED;
            PG8_STAGE(PG8_SB(0, 1), b2 + hstep, voffB);
            PG8_WAIT_V(6); PG8_BAR; PG8_MMA(1, 1, At, B1); PG8_BAR;
            PG8_LDB(B0, 1, 0); PG8_SCHED; PG8_LDA(At, 1, 0); PG8_STAGE(PG8_SA(0, 1), a2 + hstepA, voffA);
            PG8_WAIT_L(8); PG8_BAR; PG8_WAIT_L(0); PG8_MMA(0, 0, At, B0); PG8_BAR; PG8_SCHED;
            PG8_LDB(B1, 1, 1); PG8_STAGE(PG8_SB(1, 0), b3, voffB);
            PG8_BAR; PG8_WAIT_L(0); PG8_MMA(0, 1, At, B1); PG8_BAR;
            PG8_LDA(At, 1, 1); PG8_STAGE(PG8_SA(1, 0), a3, voffA);
            PG8_BAR; PG8_WAIT_L(0); PG8_MMA(1, 0, At, B0); PG8_BAR; PG8_SCHED;
            PG8_STAGE(PG8_SB(1, 1), b3 + hstep, voffB);
            PG8_WAIT_V(6); PG8_BAR; PG8_MMA(1, 1, At, B1); PG8_BAR;
            }
            if constexpr (Epi::MIDK > 0) { if (t + 2 == Epi::MIDK) E.mid(acc, cur, wr, wc, fr, fq); }
        }
        if constexpr (ALIGN_EPI) { if (wr == 0) PG8_BAR; }
        if constexpr (!Epi::AFTER_DRAIN) { E(acc, cur, wr, wc, fr, fq); S.done(cur); }
        if (!has_next) break;
#pragma unroll
        for (int a = 0; a < 2; ++a)
#pragma unroll
            for (int b = 0; b < 2; ++b)
#pragma unroll
                for (int m = 0; m < 4; ++m)
#pragma unroll
                    for (int n = 0; n < 2; ++n) acc[a][b][m][n] = (f32x4){0.f, 0.f, 0.f, 0.f};
        cur = nxt; cA = nA; cB = nB; ++ui;
        if constexpr (ALIGN_EPI) { if (wr == 1) PG8_BAR; }
    }
    PG8_WAIT_V(0);
    if constexpr (!ALIGN_EPI) { if (wr == 0) PG8_BAR; }
    PG8_BAR;
    if constexpr (Epi::AFTER_DRAIN) { E.fused(acc, cur, wr, wc, fr, fq, lds, wid, lane); S.done(cur); }
#undef PG8_SA
#undef PG8_SB
#undef PG8_STAGE
#undef PG8_LDA
#undef PG8_LDB
#undef PG8_MMA
#undef PG8_WAIT_V
#undef PG8_WAIT_L
#undef PG8_BAR
#undef PG8_SCHED
}
}

#define LAS __attribute__((address_space(3)))
typedef unsigned short bf16_t;
typedef short bf16x8 __attribute__((ext_vector_type(8)));
typedef float f32x2 __attribute__((ext_vector_type(2)));
typedef float f32x4 __attribute__((ext_vector_type(4)));
typedef float f32x16 __attribute__((ext_vector_type(16)));
typedef unsigned u32x2 __attribute__((ext_vector_type(2)));
typedef unsigned u32x4 __attribute__((ext_vector_type(4)));


constexpr int M = 65536, SEQ = 4096, D = 1024, FF = 2816, NGU = 2 * FF, NINP = 1536, NIN = 1440;
constexpr float EPS = 1e-6f;
constexpr int LDS_BYTES = 135168;
constexpr size_t MiB = 1u << 20;
constexpr size_t WS_WGU1 = 0, WS_WD1 = 11 * MiB, WS_WGU2 = 17 * MiB, WS_WD2 = 28 * MiB, WS_WIN = 34 * MiB, WS_WOUT = 37 * MiB,
                 WS_WUQ = 39 * MiB, WS_WUKV = 40 * MiB, WS_WSM = 41 * MiB, WS_COS = 42 * MiB, WS_SIN = 46 * MiB;
constexpr size_t WS_BAR = 52 * MiB;
constexpr size_t WS_SS = 50 * MiB;
constexpr size_t WS_XN = 64 * MiB;
constexpr size_t WS_HID = 192 * MiB;
constexpr size_t WS_GU = 192 * MiB, WS_GV = 256 * MiB, WS_CQN = 448 * MiB, WS_CKVN = 480 * MiB, WS_KR = 496 * MiB;
constexpr size_t WS_QRAW = 544 * MiB, WS_KVRAW = 640 * MiB, WS_QF = 768 * MiB, WS_KF = 864 * MiB, WS_VT = 960 * MiB, WS_END = 1024 * MiB;
constexpr size_t WS_Y = WS_KVRAW;

struct Params { const float* in[25]; float* out; unsigned char* ws; int ph_lo, ph_hi; };

__device__ __forceinline__ unsigned cvt_pk(float lo, float hi) { unsigned r; asm volatile("v_cvt_pk_bf16_f32 %0, %1, %2" : "=v"(r) : "v"(lo), "v"(hi)); return r; }
__device__ __forceinline__ float bflo(unsigned w) { return __builtin_bit_cast(float, w << 16); }
__device__ __forceinline__ float bfhi(unsigned w) { return __builtin_bit_cast(float, w & 0xffff0000u); }
__device__ __forceinline__ float bf2f(bf16_t h) { return __builtin_bit_cast(float, (unsigned)h << 16); }
__device__ __forceinline__ float wave_sum(float v) {
#pragma unroll
    for (int o = 1; o < 64; o <<= 1) v += __shfl_xor(v, o);
    return v;
}
__device__ __forceinline__ float silu_f(float g) { return g * __builtin_amdgcn_rcpf(1.f + __builtin_amdgcn_exp2f(-1.4426950408889634f * g)); }
__device__ __forceinline__ float gelu_f(float x) {
    const float t = x * (1.f + 0.044715f * x * x);
    return x * __builtin_amdgcn_rcpf(1.f + __builtin_amdgcn_exp2f(-2.3022081986f * t));
}
__device__ __forceinline__ float sq4(f32x4 a) { return (a.x * a.x + a.y * a.y) + (a.z * a.z + a.w * a.w); }
__device__ __forceinline__ u32x4 pack8(f32x4 a, f32x4 b) { u32x4 o; o.x = cvt_pk(a.x, a.y); o.y = cvt_pk(a.z, a.w); o.z = cvt_pk(b.x, b.y); o.w = cvt_pk(b.z, b.w); return o; }


__device__ __forceinline__ float rstd_of(const float* SS, int row, float invw) { return 1.0f / sqrtf(SS[row] * invw + EPS); }
__device__ __forceinline__ void row_stat_add(float* SS, int row, float v, int fq) {
    v += __shfl_xor(v, 16); v += __shfl_xor(v, 32);
    if (fq == 0) unsafeAtomicAdd(SS + row, v);
}
template <bool SCALE> struct EpiSwiglu {
    static constexpr bool PERM = true, AFTER_DRAIN = false; static constexpr int MIDK = 0;
    bf16_t* H; const float* SS;
    __device__ __forceinline__ void operator()(const f32x4 (&acc)[2][2][4][2], const pg8::Unit& u, int wr, int wc, int fr, int fq) const {
        const int row0 = u.pm * 256 + wr * 64 + fr, col0 = u.pn * 128 + wc * 32 + 8 * fq;
        bf16_t* hb = H + (size_t)u.pm * 256 * FF + (size_t)(col0 >> 6) * (256 * 64) + (col0 & 63);
#pragma unroll
        for (int ai = 0; ai < 2; ++ai)
#pragma unroll
            for (int m = 0; m < 4; ++m) {
                const int row = row0 + ai * 128 + m * 16;
                const float r = SCALE ? rstd_of(SS, row, 1.f / 1024.f) : 1.f;
                const f32x4 g0 = acc[ai][0][m][0] * r, g1 = acc[ai][0][m][1] * r, u0 = acc[ai][1][m][0] * r, u1 = acc[ai][1][m][1] * r;
                f32x4 h0, h1;
                h0.x = silu_f(g0.x) * u0.x; h0.y = silu_f(g0.y) * u0.y; h0.z = silu_f(g0.z) * u0.z; h0.w = silu_f(g0.w) * u0.w;
                h1.x = silu_f(g1.x) * u1.x; h1.y = silu_f(g1.y) * u1.y; h1.z = silu_f(g1.z) * u1.z; h1.w = silu_f(g1.w) * u1.w;
                *(u32x4*)(hb + (wr * 64 + fr + ai * 128 + m * 16) * 64) = pack8(h0, h1);
            }
    }
};
template <bool RF32> struct EpiResid {
    static constexpr bool PERM = true, AFTER_DRAIN = false; static constexpr int MIDK = 0;
    const float* R; bf16_t* X; float* SS; float s;
    __device__ __forceinline__ void operator()(const f32x4 (&acc)[2][2][4][2], const pg8::Unit& u, int wr, int wc, int fr, int fq) const {
        const int row0 = u.pm * 256 + wr * 64 + fr, col0 = u.pn * 256 + wc * 32 + 8 * fq;
#pragma unroll
        for (int ai = 0; ai < 2; ++ai)
#pragma unroll
            for (int m = 0; m < 4; ++m) {
                const int row = row0 + ai * 128 + m * 16; float ssq = 0.f;
#pragma unroll
                for (int bj = 0; bj < 2; ++bj) {
                    const size_t idx = (size_t)row * D + col0 + bj * 128;
                    f32x4 r0, r1;
                    if (RF32) { r0 = *(const f32x4*)(R + idx); r1 = *(const f32x4*)(R + idx + 4); }
                    else { const u32x4 w = *(const u32x4*)(X + idx); r0 = (f32x4){bflo(w.x), bfhi(w.x), bflo(w.y), bfhi(w.y)}; r1 = (f32x4){bflo(w.z), bfhi(w.z), bflo(w.w), bfhi(w.w)}; }
                    const f32x4 v0 = r0 + acc[ai][bj][m][0] * s, v1 = r1 + acc[ai][bj][m][1] * s;
                    ssq += sq4(v0) + sq4(v1);
                    *(u32x4*)(X + idx) = pack8(v0, v1);
                }
                row_stat_add(SS, row, ssq, fq);
            }
    }
};
struct EpiResidY {
    static constexpr bool PERM = true, AFTER_DRAIN = false; static constexpr int MIDK = 8;
    bf16_t* X; float* SS; const float* SSB; const LAS float* F;
    __device__ __forceinline__ void mid(f32x4 (&acc)[2][2][4][2], const pg8::Unit& u, int wr, int wc, int fr, int fq) const {
#pragma unroll
        for (int ai = 0; ai < 2; ++ai)
#pragma unroll
            for (int m = 0; m < 4; ++m) {
                const float f = F[wr * 64 + fr + ai * 128 + m * 16];
#pragma unroll
                for (int bj = 0; bj < 2; ++bj) { acc[ai][bj][m][0] = acc[ai][bj][m][0] * f; acc[ai][bj][m][1] = acc[ai][bj][m][1] * f; }
            }
    }
    __device__ __forceinline__ void operator()(const f32x4 (&acc)[2][2][4][2], const pg8::Unit& u, int wr, int wc, int fr, int fq) const {
        const int row0 = u.pm * 256 + wr * 64 + fr, col0 = u.pn * 256 + wc * 32 + 8 * fq;
#pragma unroll
        for (int ai = 0; ai < 2; ++ai)
#pragma unroll
            for (int m = 0; m < 4; ++m) {
                const int row = row0 + ai * 128 + m * 16; float ssq = 0.f;
                const float rb = rstd_of(SSB, row, 1.f / 512.f);
#pragma unroll
                for (int bj = 0; bj < 2; ++bj) {
                    const size_t idx = (size_t)row * D + col0 + bj * 128;
                    const u32x4 w = *(const u32x4*)(X + idx);
                    const f32x4 r0 = {bflo(w.x), bfhi(w.x), bflo(w.y), bfhi(w.y)}, r1 = {bflo(w.z), bfhi(w.z), bflo(w.w), bfhi(w.w)};
                    const f32x4 v0 = r0 + acc[ai][bj][m][0] * rb, v1 = r1 + acc[ai][bj][m][1] * rb;
                    ssq += sq4(v0) + sq4(v1);
                    *(u32x4*)(X + idx) = pack8(v0, v1);
                }
                row_stat_add(SS, row, ssq, fq);
            }
    }
};
struct OrderY : pg8::StaticOrder {
    const float* SSA; const float* SSB; LAS float* F;
    __device__ __forceinline__ void a_ready(const pg8::Unit& u) const {
        const int t = threadIdx.x;
        if (t < 256) { const int row = u.pm * 256 + t; F[t] = sqrtf((SSB[row] * (1.f / 512.f) + EPS) / (SSA[row] * (1.f / 512.f) + EPS)); }
    }
};
struct EpiH {
    static constexpr bool PERM = true, AFTER_DRAIN = false; static constexpr int MIDK = 0;
    bf16_t* GU; bf16_t* GV; bf16_t* CQ; bf16_t* CKV; float* KR; const float* SS1; float* SSQ; float* SSKV;
    __device__ __forceinline__ void operator()(const f32x4 (&acc)[2][2][4][2], const pg8::Unit& u, int wr, int wc, int fr, int fq) const {
        const int row0 = u.pm * 256 + wr * 64 + fr, colw = wc * 32 + 8 * fq;
        if (u.pn < 4) {
            bf16_t* dst = (u.pn < 2 ? GU : GV) + (u.pn & 1) * 256 + colw;
#pragma unroll
            for (int ai = 0; ai < 2; ++ai)
#pragma unroll
                for (int m = 0; m < 4; ++m) {
                    const int row = row0 + ai * 128 + m * 16; const float r = rstd_of(SS1, row, 1.f / 1024.f);
#pragma unroll
                    for (int bj = 0; bj < 2; ++bj) {
                        const f32x4 a = acc[ai][bj][m][0] * r, b = acc[ai][bj][m][1] * r;
                        f32x4 ga, gb; ga.x = gelu_f(a.x); ga.y = gelu_f(a.y); ga.z = gelu_f(a.z); ga.w = gelu_f(a.w);
                        gb.x = gelu_f(b.x); gb.y = gelu_f(b.y); gb.z = gelu_f(b.z); gb.w = gelu_f(b.w);
                        *(u32x4*)(dst + (size_t)row * 512 + bj * 128) = pack8(ga, gb);
                    }
                }
        } else if (u.pn == 4) {
#pragma unroll
            for (int ai = 0; ai < 2; ++ai)
#pragma unroll
                for (int m = 0; m < 4; ++m) {
                    const int row = row0 + ai * 128 + m * 16; const float r = rstd_of(SS1, row, 1.f / 1024.f); float ssq = 0.f;
#pragma unroll
                    for (int bj = 0; bj < 2; ++bj) {
                        const f32x4 a = acc[ai][bj][m][0] * r, b = acc[ai][bj][m][1] * r; ssq += sq4(a) + sq4(b);
                        *(u32x4*)(CQ + (size_t)row * 256 + bj * 128 + colw) = pack8(a, b);
                    }
                    row_stat_add(SSQ, row, ssq, fq);
                }
        } else {
#pragma unroll
            for (int ai = 0; ai < 2; ++ai)
#pragma unroll
                for (int m = 0; m < 4; ++m) {
                    const int row = row0 + ai * 128 + m * 16; const float r = rstd_of(SS1, row, 1.f / 1024.f);
                    const f32x4 a = acc[ai][0][m][0] * r, b = acc[ai][0][m][1] * r;
                    *(u32x4*)(CKV + (size_t)row * 128 + colw) = pack8(a, b);
                    row_stat_add(SSKV, row, sq4(a) + sq4(b), fq);
                    if (wc == 0) { float* d = KR + (size_t)row * 32 + 8 * fq; *(f32x4*)d = acc[ai][1][m][0] * r; *(f32x4*)(d + 4) = acc[ai][1][m][1] * r; }
                }
        }
    }
};
struct EpiPlain {
    static constexpr bool PERM = true, AFTER_DRAIN = false; static constexpr int MIDK = 0;
    bf16_t* O; int ldc; const float* SS; float invw;
    __device__ __forceinline__ void operator()(const f32x4 (&acc)[2][2][4][2], const pg8::Unit& u, int wr, int wc, int fr, int fq) const {
        const int row0 = u.pm * 256 + wr * 64 + fr, col0 = u.pn * 256 + wc * 32 + 8 * fq;
#pragma unroll
        for (int ai = 0; ai < 2; ++ai)
#pragma unroll
            for (int m = 0; m < 4; ++m) {
                const int row = row0 + ai * 128 + m * 16; const float r = rstd_of(SS, row, invw);
#pragma unroll
                for (int bj = 0; bj < 2; ++bj)
                    *(u32x4*)(O + (size_t)row * ldc + col0 + bj * 128) = pack8(acc[ai][bj][m][0] * r, acc[ai][bj][m][1] * r);
            }
    }
};

__device__ __forceinline__ void tr_tile(const float* W, int ldw, const float* gain, bf16_t* dst, int dpitch, int mode, int tile, int nb, LAS float* scr, int lane) {
    const int kb = tile / nb, nbi = tile - kb * nb, k0 = kb * 64, n0 = nbi * 32;
    float wv[32];
#pragma unroll
    for (int i = 0; i < 32; ++i) wv[i] = W[(size_t)(k0 + 2 * i + (lane >> 5)) * ldw + n0 + (lane & 31)];
    if (gain) {
#pragma unroll
        for (int i = 0; i < 32; ++i) wv[i] *= gain[k0 + 2 * i + (lane >> 5)];
    }
#pragma unroll
    for (int i = 0; i < 32; ++i) scr[(2 * i + (lane >> 5)) * 33 + (lane & 31)] = wv[i];
    asm volatile("s_waitcnt lgkmcnt(0)" ::: "memory");
    const int c = lane & 7;
#pragma unroll
    for (int j = 0; j < 4; ++j) { const int n = (lane >> 3) + 8 * j; const LAS float* s = scr + (8 * c) * 33 + n;
        u32x4 o; o.x = cvt_pk(s[0], s[33]); o.y = cvt_pk(s[66], s[99]); o.z = cvt_pk(s[132], s[165]); o.w = cvt_pk(s[198], s[231]);
        const int nn = n0 + n; const int drow = (mode == 0) ? nn : ((nn >> 7) * 256 + (nn & 127) + (mode == 2 ? 128 : 0));
        *(u32x4*)(dst + (size_t)drow * dpitch + k0 + 8 * c) = o; }
    asm volatile("s_waitcnt lgkmcnt(0)" ::: "memory");
}
__device__ __forceinline__ void rownorm1024(const float* src, bf16_t* dst, int lane) {
    const f32x4* s4 = (const f32x4*)src;
    const f32x4 a0 = s4[2 * lane], a1 = s4[2 * lane + 1], b0 = s4[128 + 2 * lane], b1 = s4[129 + 2 * lane];
    const float ss = wave_sum((sq4(a0) + sq4(a1)) + (sq4(b0) + sq4(b1)));
    const float r = 1.0f / sqrtf(ss * (1.f / 1024.f) + EPS);
    *(u32x4*)(dst + 8 * lane) = pack8(a0 * r, a1 * r); *(u32x4*)(dst + 512 + 8 * lane) = pack8(b0 * r, b1 * r);
}

__device__ __forceinline__ void p0_prologue(const Params& p, LAS unsigned char* lds, int G) {
    const int tid = opaque_tid(), lane = tid & 63, wave = tid >> 6;
    unsigned char* ws = p.ws;
    const int gw = blockIdx.x * 8 + wave, NGW = G * 8;
    for (int m = gw; m < M; m += 4 * NGW) {
        f32x4 a0[4], a1[4], b0[4], b1[4];
#pragma unroll
        for (int k = 0; k < 4; ++k) { const int mm = (m + k * NGW < M) ? m + k * NGW : m; const f32x4* s4 = (const f32x4*)(p.in[0] + (size_t)mm * D);
            a0[k] = s4[2 * lane]; a1[k] = s4[2 * lane + 1]; b0[k] = s4[128 + 2 * lane]; b1[k] = s4[129 + 2 * lane]; }
#pragma unroll
        for (int k = 0; k < 4; ++k) { const int mm = m + k * NGW; if (mm < M) {
            const float ss = wave_sum((sq4(a0[k]) + sq4(a1[k])) + (sq4(b0[k]) + sq4(b1[k])));
            const float r = 1.0f / sqrtf(ss * (1.f / 1024.f) + EPS);
            bf16_t* dst = (bf16_t*)(ws + WS_XN) + (size_t)mm * D;
            *(u32x4*)(dst + 8 * lane) = pack8(a0[k] * r, a1[k] * r); *(u32x4*)(dst + 512 + 8 * lane) = pack8(b0[k] * r, b1[k] * r); } }
    }
    LAS float* scr = (LAS float*)lds + wave * (64 * 33);
    constexpr int T_GU = 16 * 88, T_DN = 44 * 32, T_IN = 16 * 45, T_UQ = 4 * 24, T_UKV = 2 * 32, T_OUT = 8 * 32;
    constexpr int NT = 4 * T_GU + 2 * T_DN + T_IN + T_UQ + T_UKV + 2 * T_OUT;
    for (int it = gw; it < NT; it += NGW) {
        int r = it;
        if (r < T_GU) { tr_tile(p.in[3], FF, p.in[2], (bf16_t*)(ws + WS_WGU1), D, 1, r, 88, scr, lane); continue; } r -= T_GU;
        if (r < T_GU) { tr_tile(p.in[4], FF, p.in[2], (bf16_t*)(ws + WS_WGU1), D, 2, r, 88, scr, lane); continue; } r -= T_GU;
        if (r < T_GU) { tr_tile(p.in[21], FF, p.in[20], (bf16_t*)(ws + WS_WGU2), D, 1, r, 88, scr, lane); continue; } r -= T_GU;
        if (r < T_GU) { tr_tile(p.in[22], FF, p.in[20], (bf16_t*)(ws + WS_WGU2), D, 2, r, 88, scr, lane); continue; } r -= T_GU;
        if (r < T_DN) { tr_tile(p.in[5], D, nullptr, (bf16_t*)(ws + WS_WD1), FF, 0, r, 32, scr, lane); continue; } r -= T_DN;
        if (r < T_DN) { tr_tile(p.in[23], D, nullptr, (bf16_t*)(ws + WS_WD2), FF, 0, r, 32, scr, lane); continue; } r -= T_DN;
        if (r < T_IN) { tr_tile(p.in[7], NIN, p.in[6], (bf16_t*)(ws + WS_WIN), D, 0, r, 45, scr, lane); continue; } r -= T_IN;
        if (r < T_UQ) { tr_tile(p.in[12], 768, p.in[11], (bf16_t*)(ws + WS_WUQ), 256, 0, r, 24, scr, lane); continue; } r -= T_UQ;
        if (r < T_UKV) { tr_tile(p.in[14], 1024, p.in[13], (bf16_t*)(ws + WS_WUKV), 128, 0, r, 32, scr, lane); continue; } r -= T_UKV;
        if (r < T_OUT) { tr_tile(p.in[19], D, p.in[17], (bf16_t*)(ws + WS_WOUT), D, 0, r, 32, scr, lane); continue; } r -= T_OUT;
        tr_tile(p.in[19] + (size_t)512 * D, D, p.in[18], (bf16_t*)(ws + WS_WOUT) + 512, D, 0, r, 32, scr, lane);
    }
    const int gt = blockIdx.x * 512 + tid, NGT = G * 512;
    { f32x4* z = (f32x4*)(ws + WS_SS); const f32x4 zero = {0.f, 0.f, 0.f, 0.f};
      for (int i = gt; i < 7 * M / 4; i += NGT) z[i] = zero; }
    { u32x4* z = (u32x4*)((bf16_t*)(ws + WS_WIN) + (size_t)NIN * D); const u32x4 zero = {0u, 0u, 0u, 0u};
      for (int i = gt; i < (NINP - NIN) * D / 8; i += NGT) z[i] = zero; }
    { bf16_t* wsm = (bf16_t*)(ws + WS_WSM);
      for (int i = gt; i < 4 * 128 * 128 / 2; i += NGT) { const int e = 2 * i, ii = (e >> 7) & 127, jj = e & 127;
          const f32x2 v = *(const f32x2*)(p.in[9] + e); const bool keep = (jj >> 6) <= (ii >> 6);
          *(unsigned*)(wsm + e) = keep ? cvt_pk(v.x, v.y) : 0u; } }
    { float* ct = (float*)(ws + WS_COS); float* st = (float*)(ws + WS_SIN); const int* pos = (const int*)p.in[1];
      for (int i = gt; i < M * 16; i += NGT) { const int f = i & 15;
          const float inv = exp2f(-(float)f * (13.287712379549449f / 16.f));
          const float ang = (float)pos[i >> 4] * inv;
          double rev = (double)ang * 0.15915494309189535; rev -= rint(rev);
          const float rr = (float)(rev * 6.283185307179586);
          ct[i] = cosf(rr); st[i] = sinf(rr); } }
}

__device__ __forceinline__ void ynorm_phase(bf16_t* Y, int G) {
    const int tid_ = opaque_tid(), lane = tid_ & 63, gw = blockIdx.x * 8 + (tid_ >> 6), NGW = G * 8;
    for (int m = gw; m < M; m += 4 * NGW) {
        u32x4 a[4], b[4];
#pragma unroll
        for (int k = 0; k < 4; ++k) { const int mm = (m + k * NGW < M) ? m + k * NGW : m; const bf16_t* y = Y + (size_t)mm * 1024;
            a[k] = *(const u32x4*)(y + 8 * lane); b[k] = *(const u32x4*)(y + 512 + 8 * lane); }
#pragma unroll
        for (int k = 0; k < 4; ++k) { const int mm = m + k * NGW; if (mm < M) {
            bf16_t* y = Y + (size_t)mm * 1024;
            const f32x4 a0 = {bflo(a[k].x), bfhi(a[k].x), bflo(a[k].y), bfhi(a[k].y)}, a1 = {bflo(a[k].z), bfhi(a[k].z), bflo(a[k].w), bfhi(a[k].w)};
            const f32x4 b0 = {bflo(b[k].x), bfhi(b[k].x), bflo(b[k].y), bfhi(b[k].y)}, b1 = {bflo(b[k].z), bfhi(b[k].z), bflo(b[k].w), bfhi(b[k].w)};
            const float sa = wave_sum(sq4(a0) + sq4(a1)), sb = wave_sum(sq4(b0) + sq4(b1));
            const float ra = 1.0f / sqrtf(sa * (1.f / 512.f) + EPS), rb = 1.0f / sqrtf(sb * (1.f / 512.f) + EPS);
            *(u32x4*)(y + 8 * lane) = pack8(a0 * ra, a1 * ra); *(u32x4*)(y + 512 + 8 * lane) = pack8(b0 * rb, b1 * rb); } }
    }
}
__device__ __forceinline__ void final_phase(const bf16_t* X, const float* SS, const float* gain, float* out, int G) {
    const int tid_ = opaque_tid(), lane = tid_ & 63, gw = blockIdx.x * 8 + (tid_ >> 6), NGW = G * 8;
    const f32x4* g4 = (const f32x4*)gain;
    const f32x4 ga0 = g4[2 * lane], ga1 = g4[2 * lane + 1], gb0 = g4[128 + 2 * lane], gb1 = g4[129 + 2 * lane];
    for (int m = gw; m < M; m += 4 * NGW) {
        u32x4 a[4], b[4]; float sv[4];
#pragma unroll
        for (int k = 0; k < 4; ++k) { const int mm = (m + k * NGW < M) ? m + k * NGW : m; const bf16_t* x = X + (size_t)mm * D;
            a[k] = *(const u32x4*)(x + 8 * lane); b[k] = *(const u32x4*)(x + 512 + 8 * lane); sv[k] = SS[mm]; }
#pragma unroll
        for (int k = 0; k < 4; ++k) { const int mm = m + k * NGW; if (mm < M) {
            f32x4* o4 = (f32x4*)(out + (size_t)mm * D);
            const float r = 1.0f / sqrtf(sv[k] * (1.f / 1024.f) + EPS);
            const f32x4 a0 = {bflo(a[k].x), bfhi(a[k].x), bflo(a[k].y), bfhi(a[k].y)}, a1 = {bflo(a[k].z), bfhi(a[k].z), bflo(a[k].w), bfhi(a[k].w)};
            const f32x4 b0 = {bflo(b[k].x), bfhi(b[k].x), bflo(b[k].y), bfhi(b[k].y)}, b1 = {bflo(b[k].z), bfhi(b[k].z), bflo(b[k].w), bfhi(b[k].w)};
            o4[2 * lane] = a0 * r * ga0; o4[2 * lane + 1] = a1 * r * ga1; o4[128 + 2 * lane] = b0 * r * gb0; o4[129 + 2 * lane] = b1 * r * gb1; } }
    }
}

constexpr float QSCALE = 0.10206207261596577f * 1.4426950408889634f;
__device__ __forceinline__ void finalize_phase(const Params& p, LAS unsigned char* lds, int G) {
    unsigned char* ws = p.ws;
    const int tid = opaque_tid(), lane = tid & 63, wave = tid >> 6, gw = blockIdx.x * 8 + wave, NGW = G * 8;
    const bf16_t* QRAW = (const bf16_t*)(ws + WS_QRAW); const bf16_t* KVRAW = (const bf16_t*)(ws + WS_KVRAW); const float* KR = (const float*)(ws + WS_KR);
    const float* COS = (const float*)(ws + WS_COS); const float* SIN = (const float*)(ws + WS_SIN);
    bf16_t* KF = (bf16_t*)(ws + WS_KF); bf16_t* VT = (bf16_t*)(ws + WS_VT);
    const int h = lane >> 3, sub = lane & 7;
    const float* gq = p.in[15]; const float* gk = p.in[16];
    const f32x4 gqa = *(const f32x4*)(gq + 8 * sub), gqb = *(const f32x4*)(gq + 8 * sub + 4); const f32x2 gq1 = *(const f32x2*)(gq + 64 + 2 * sub), gq2 = *(const f32x2*)(gq + 80 + 2 * sub);
    const f32x4 gka = *(const f32x4*)(gk + 8 * sub), gkb = *(const f32x4*)(gk + 8 * sub + 4); const f32x2 gk1 = *(const f32x2*)(gk + 64 + 2 * sub), gk2 = *(const f32x2*)(gk + 80 + 2 * sub);
    for (int rowb = gw; rowb < M; rowb += 8 * NGW) {
        u32x4 kn8[8]; f32x2 kx1[8], kx2[8], csv[8], snv[8];
#pragma unroll
        for (int k = 0; k < 8; ++k) {
            const int row = (rowb + k * NGW < M) ? rowb + k * NGW : rowb;
            const bf16_t* kk = KVRAW + (size_t)row * 1024 + h * 128;
            kn8[k] = *(const u32x4*)(kk + 8 * sub);
            kx1[k] = *(const f32x2*)(KR + (size_t)row * 32 + 2 * sub); kx2[k] = *(const f32x2*)(KR + (size_t)row * 32 + 16 + 2 * sub);
            csv[k] = *(const f32x2*)(COS + (size_t)row * 16 + 2 * sub); snv[k] = *(const f32x2*)(SIN + (size_t)row * 16 + 2 * sub);
        }
#pragma unroll
        for (int k = 0; k < 8; ++k) {
            const int row = rowb + k * NGW;
            if (row < M) {
                const int b = row >> 12, s = row & 4095;
                const f32x2 cs = csv[k], sn = snv[k];
                const size_t orow = ((size_t)(b * 8 + h) * SEQ + s) * 96;
                {
                    const u32x4 n8 = kn8[k];
                    f32x4 a0 = {bflo(n8.x), bfhi(n8.x), bflo(n8.y), bfhi(n8.y)}, a1 = {bflo(n8.z), bfhi(n8.z), bflo(n8.w), bfhi(n8.w)};
                    f32x2 x1 = kx1[k], x2 = kx2[k];
                    float ss = sq4(a0) + sq4(a1) + (x1.x * x1.x + x1.y * x1.y) + (x2.x * x2.x + x2.y * x2.y);
                    ss += __shfl_xor(ss, 1); ss += __shfl_xor(ss, 2); ss += __shfl_xor(ss, 4);
                    const float r = 1.0f / sqrtf(ss * (1.f / 96.f) + EPS);
                    a0 = a0 * gka * r; a1 = a1 * gkb * r; x1 = x1 * gk1 * r; x2 = x2 * gk2 * r;
                    const f32x2 o1 = x1 * cs - x2 * sn, o2 = x2 * cs + x1 * sn;
                    *(u32x4*)(KF + orow + 8 * sub) = pack8(a0, a1);
                    *(unsigned*)(KF + orow + 64 + 2 * sub) = cvt_pk(o1.x, o1.y); *(unsigned*)(KF + orow + 80 + 2 * sub) = cvt_pk(o2.x, o2.y);
                }
            }
        }
    }
    LAS bf16_t* buf = (LAS bf16_t*)lds;
    u32x4 vp[8];
    if ((int)blockIdx.x < M / 64) {
#pragma unroll
        for (int i = 0; i < 8; ++i) { const int pc = tid + 512 * i, tok = pc >> 6, c = pc & 63;
            vp[i] = *(const u32x4*)(KVRAW + (size_t)(blockIdx.x * 64 + tok) * 1024 + (c >> 3) * 128 + 64 + (c & 7) * 8); }
    }
    for (int t = blockIdx.x; t < M / 64; t += G) {
        const int row0 = t * 64;
#pragma unroll
        for (int i = 0; i < 8; ++i) { const int pc = tid + 512 * i, tok = pc >> 6, c = pc & 63; *(LAS u32x4*)(buf + tok * 520 + c * 8) = vp[i]; }
        __syncthreads();
        if (t + G < M / 64) {
#pragma unroll
            for (int i = 0; i < 8; ++i) { const int pc = tid + 512 * i, tok = pc >> 6, c = pc & 63;
                vp[i] = *(const u32x4*)(KVRAW + (size_t)((t + G) * 64 + tok) * 1024 + (c >> 3) * 128 + 64 + (c & 7) * 8); }
        }
        const int b = row0 >> 12, s0 = row0 & 4095;
        bf16_t* dst = VT + ((size_t)(b * 8) * 64 + tid) * SEQ + s0;
#pragma unroll
        for (int i = 0; i < 8; ++i) {
            u32x4 o;
            o.x = (unsigned)buf[(8 * i + 0) * 520 + tid] | ((unsigned)buf[(8 * i + 1) * 520 + tid] << 16);
            o.y = (unsigned)buf[(8 * i + 2) * 520 + tid] | ((unsigned)buf[(8 * i + 3) * 520 + tid] << 16);
            o.z = (unsigned)buf[(8 * i + 4) * 520 + tid] | ((unsigned)buf[(8 * i + 5) * 520 + tid] << 16);
            o.w = (unsigned)buf[(8 * i + 6) * 520 + tid] | ((unsigned)buf[(8 * i + 7) * 520 + tid] << 16);
            *(u32x4*)(dst + 8 * i) = o;
        }
        __syncthreads();
    }
}

__device__ __forceinline__ void gmlp_phase(const Params& p, LAS unsigned char* lds, int G) {
    unsigned char* ws = p.ws;
    const int tid = opaque_tid(), lane = tid & 63, wave = tid >> 6, l32 = lane & 31, hi = lane >> 5, wi = wave >> 1, wc = wave & 1;
    const bf16_t* GU = (const bf16_t*)(ws + WS_GU); const bf16_t* GV = (const bf16_t*)(ws + WS_GV); const bf16_t* WSM = (const bf16_t*)(ws + WS_WSM);
    bf16_t* Y = (bf16_t*)(ws + WS_Y);
    const float* gvn = p.in[8]; const float* bs = p.in[10];
    float* SSA = (float*)(ws + WS_SS) + 5 * M;
    LAS bf16_t* vT = (LAS bf16_t*)lds;
    const int j = tid >> 2, part = tid & 3;
    const int nunits = M / 128;
    if ((int)blockIdx.x >= nunits) return;
    u32x4 v0, v1, v2, v3;
    { const u32x4* src = (const u32x4*)(GV + (size_t)(blockIdx.x * 128 + j) * 512 + part * 32); v0 = src[0]; v1 = src[1]; v2 = src[2]; v3 = src[3]; }
    for (int unit = blockIdx.x; unit < nunits; unit += G) {
        const int row0 = unit * 128;
        for (int g = 0; g < 4; ++g) {
            const int i = 32 * wi + l32; const size_t tok = (size_t)(row0 + i);
            const int cb = g * 128 + 64 * wc + 4 * hi;
            const bf16_t* ap = WSM + (size_t)(g * 128 + i) * 128 + 8 * hi;
            bf16x8 wf[8]; u32x2 guv[8];
#pragma unroll
            for (int ks = 0; ks < 8; ++ks) wf[ks] = *(const bf16x8*)(ap + 16 * ks);
#pragma unroll
            for (int q = 0; q < 4; ++q) { guv[2 * q] = *(const u32x2*)(GU + tok * 512 + cb + 8 * q); guv[2 * q + 1] = *(const u32x2*)(GU + tok * 512 + cb + 32 + 8 * q); }
            const float bi = bs[g * 128 + i];
            {
                float f[32];
                f[0] = bflo(v0.x); f[1] = bfhi(v0.x); f[2] = bflo(v0.y); f[3] = bfhi(v0.y); f[4] = bflo(v0.z); f[5] = bfhi(v0.z); f[6] = bflo(v0.w); f[7] = bfhi(v0.w);
                f[8] = bflo(v1.x); f[9] = bfhi(v1.x); f[10] = bflo(v1.y); f[11] = bfhi(v1.y); f[12] = bflo(v1.z); f[13] = bfhi(v1.z); f[14] = bflo(v1.w); f[15] = bfhi(v1.w);
                f[16] = bflo(v2.x); f[17] = bfhi(v2.x); f[18] = bflo(v2.y); f[19] = bfhi(v2.y); f[20] = bflo(v2.z); f[21] = bfhi(v2.z); f[22] = bflo(v2.w); f[23] = bfhi(v2.w);
                f[24] = bflo(v3.x); f[25] = bfhi(v3.x); f[26] = bflo(v3.y); f[27] = bfhi(v3.y); f[28] = bflo(v3.z); f[29] = bfhi(v3.z); f[30] = bflo(v3.w); f[31] = bfhi(v3.w);
                float ss = 0.f;
#pragma unroll
                for (int e = 0; e < 32; ++e) ss += f[e] * f[e];
                ss += __shfl_xor(ss, 1); ss += __shfl_xor(ss, 2);
                const float r = 1.0f / sqrtf(ss * (1.f / 128.f) + EPS);
#pragma unroll
                for (int e = 0; e < 32; e += 2) { const unsigned w = cvt_pk(f[e] * r, f[e + 1] * r);
                    vT[(part * 32 + e) * 136 + j] = (bf16_t)(w & 0xffffu); vT[(part * 32 + e + 1) * 136 + j] = (bf16_t)(w >> 16); }
            }
            {
                const int gn = (g + 1) & 3, un = (g == 3) ? unit + G : unit;
                if (un < nunits) { const u32x4* src = (const u32x4*)(GV + (size_t)(un * 128 + j) * 512 + gn * 128 + part * 32); v0 = src[0]; v1 = src[1]; v2 = src[2]; v3 = src[3]; }
            }
            __syncthreads();
            f32x16 acc0, acc1;
#pragma unroll
            for (int e = 0; e < 16; ++e) { acc0[e] = 0.f; acc1[e] = 0.f; }
            const LAS bf16_t* bp0 = vT + (64 * wc + l32) * 136 + 8 * hi; const LAS bf16_t* bp1 = bp0 + 32 * 136;
#pragma unroll
            for (int ks = 0; ks < 8; ++ks) {
                const bf16x8 b0 = *(const LAS bf16x8*)(bp0 + 16 * ks), b1 = *(const LAS bf16x8*)(bp1 + 16 * ks);
                acc0 = __builtin_amdgcn_mfma_f32_32x32x16_bf16(b0, wf[ks], acc0, 0, 0, 0);
                acc1 = __builtin_amdgcn_mfma_f32_32x32x16_bf16(b1, wf[ks], acc1, 0, 0, 0);
            }
            float yss = 0.f;
#pragma unroll
            for (int q = 0; q < 4; ++q) {
#pragma unroll
                for (int hb = 0; hb < 2; ++hb) {
                    const int c = cb + 32 * hb + 8 * q;
                    const u32x2 gu = guv[2 * q + hb]; const f32x4 gv = *(const f32x4*)(gvn + c);
                    const float a0 = hb ? acc1[4 * q] : acc0[4 * q], a1 = hb ? acc1[4 * q + 1] : acc0[4 * q + 1], a2 = hb ? acc1[4 * q + 2] : acc0[4 * q + 2], a3 = hb ? acc1[4 * q + 3] : acc0[4 * q + 3];
                    const float y0 = bflo(gu.x) * (gv.x * a0 + bi), y1 = bfhi(gu.x) * (gv.y * a1 + bi), y2 = bflo(gu.y) * (gv.z * a2 + bi), y3 = bfhi(gu.y) * (gv.w * a3 + bi);
                    yss += (y0 * y0 + y1 * y1) + (y2 * y2 + y3 * y3);
                    u32x2 o; o.x = cvt_pk(y0, y1); o.y = cvt_pk(y2, y3);
                    *(u32x2*)(Y + tok * 1024 + c) = o;
                }
            }
            yss += __shfl_xor(yss, 32);
            if (hi == 0) unsafeAtomicAdd(SSA + tok, yss);
            __syncthreads();
        }
    }
}

#define LBAR() do { asm volatile("s_waitcnt lgkmcnt(0)" ::: "memory"); __builtin_amdgcn_s_barrier(); asm volatile("" ::: "memory"); } while (0)
__device__ __forceinline__ float max3f(float a, float b, float c) { float r; asm("v_max3_f32 %0, %1, %2, %3" : "=v"(r) : "v"(a), "v"(b), "v"(c)); return r; }
constexpr int KPITCH = 208, VPITCH = 264, KBUF = 128 * KPITCH, VBUF = 64 * VPITCH, VOFF = 2 * KBUF;
#define ATT_LOAD(ST) do { const int sl_ = (ST); const bf16_t* kb_ = kbase + (size_t)sl_ * 128 * 96; const bf16_t* vb_ = vbase + sl_ * 128; \
    rk0 = *(const u32x4*)(kb_ + (size_t)kr0 * 96 + kc0 * 8); rk1 = *(const u32x4*)(kb_ + (size_t)kr1 * 96 + kc1 * 8); rk2 = *(const u32x4*)(kb_ + (size_t)kr2 * 96 + kc2 * 8); \
    rv0 = *(const u32x4*)(vb_ + (size_t)vr0 * SEQ + vc0 * 8); rv1 = *(const u32x4*)(vb_ + (size_t)(vr0 + 32) * SEQ + vc0 * 8); } while (0)
#define ATT_STORE(B) do { LAS unsigned char* kd_ = lds + (B) * KBUF; LAS unsigned char* vd_ = lds + VOFF + (B) * VBUF + vr0 * VPITCH + vc0 * 16; \
    *(LAS u32x4*)(kd_ + kr0 * KPITCH + kc0 * 16) = rk0; *(LAS u32x4*)(kd_ + kr1 * KPITCH + kc1 * 16) = rk1; *(LAS u32x4*)(kd_ + kr2 * KPITCH + kc2 * 16) = rk2; \
    *(LAS u32x2*)(vd_) = (u32x2){rv0.x, rv0.y}; *(LAS u32x2*)(vd_ + 8) = (u32x2){rv0.z, rv0.w}; \
    *(LAS u32x2*)(vd_ + 32 * VPITCH) = (u32x2){rv1.x, rv1.y}; *(LAS u32x2*)(vd_ + 32 * VPITCH + 8) = (u32x2){rv1.z, rv1.w}; } while (0)
#define ATT_COMPUTE(BUF, J) do { \
    const LAS unsigned char* Kb_ = lds + (BUF) * KBUF + (64 * (J) + l32) * KPITCH + hi * 16; \
    const LAS unsigned char* Vb_ = lds + VOFF + (BUF) * VBUF + l32 * VPITCH + 128 * (J) + hi * 8; \
    bf16x8 kf_[12]; \
    _Pragma("unroll") for (int ks_ = 0; ks_ < 6; ++ks_) { kf_[2 * ks_] = *(const LAS bf16x8*)(Kb_ + ks_ * 32); kf_[2 * ks_ + 1] = *(const LAS bf16x8*)(Kb_ + 32 * KPITCH + ks_ * 32); } \
    __builtin_amdgcn_sched_barrier(0); \
    f32x16 s0 = __builtin_amdgcn_mfma_f32_32x32x16_bf16(kf_[0], qf[0], negv, 0, 0, 0), s1 = __builtin_amdgcn_mfma_f32_32x32x16_bf16(kf_[1], qf[0], negv, 0, 0, 0); \
    _Pragma("unroll") for (int ks_ = 1; ks_ < 6; ++ks_) { \
        s0 = __builtin_amdgcn_mfma_f32_32x32x16_bf16(kf_[2 * ks_], qf[ks_], s0, 0, 0, 0); \
        s1 = __builtin_amdgcn_mfma_f32_32x32x16_bf16(kf_[2 * ks_ + 1], qf[ks_], s1, 0, 0, 0); } \
    __builtin_amdgcn_sched_barrier(0); \
    u32x2 vf_[16]; \
    _Pragma("unroll") for (int k4_ = 0; k4_ < 4; ++k4_) { \
        vf_[4 * k4_] = *(const LAS u32x2*)(Vb_ + k4_ * 32); vf_[4 * k4_ + 1] = *(const LAS u32x2*)(Vb_ + k4_ * 32 + 16); \
        vf_[4 * k4_ + 2] = *(const LAS u32x2*)(Vb_ + 32 * VPITCH + k4_ * 32); vf_[4 * k4_ + 3] = *(const LAS u32x2*)(Vb_ + 32 * VPITCH + k4_ * 32 + 16); } \
    __builtin_amdgcn_sched_barrier(0); \
    _Pragma("unroll") for (int e_ = 0; e_ < 16; ++e_) { s0[e_] = __builtin_amdgcn_exp2f(s0[e_]); s1[e_] = __builtin_amdgcn_exp2f(s1[e_]); } \
    { const f32x16 sm_ = s0 + s1; \
      const float pa_ = (sm_[0] + sm_[1]) + (sm_[2] + sm_[3]), pb2_ = (sm_[4] + sm_[5]) + (sm_[6] + sm_[7]), pc_ = (sm_[8] + sm_[9]) + (sm_[10] + sm_[11]), pd_ = (sm_[12] + sm_[13]) + (sm_[14] + sm_[15]); \
      lsum += (pa_ + pb2_) + (pc_ + pd_); } \
    u32x4 pw_[4]; \
    pw_[0].x = cvt_pk(s0[0], s0[1]); pw_[0].y = cvt_pk(s0[2], s0[3]); pw_[0].z = cvt_pk(s0[4], s0[5]); pw_[0].w = cvt_pk(s0[6], s0[7]); \
    pw_[1].x = cvt_pk(s0[8], s0[9]); pw_[1].y = cvt_pk(s0[10], s0[11]); pw_[1].z = cvt_pk(s0[12], s0[13]); pw_[1].w = cvt_pk(s0[14], s0[15]); \
    pw_[2].x = cvt_pk(s1[0], s1[1]); pw_[2].y = cvt_pk(s1[2], s1[3]); pw_[2].z = cvt_pk(s1[4], s1[5]); pw_[2].w = cvt_pk(s1[6], s1[7]); \
    pw_[3].x = cvt_pk(s1[8], s1[9]); pw_[3].y = cvt_pk(s1[10], s1[11]); pw_[3].z = cvt_pk(s1[12], s1[13]); pw_[3].w = cvt_pk(s1[14], s1[15]); \
    __builtin_amdgcn_sched_barrier(0); \
    _Pragma("unroll") for (int k4_ = 0; k4_ < 4; ++k4_) { \
        const bf16x8 pb_ = __builtin_bit_cast(bf16x8, pw_[k4_]); \
        const u32x4 va_ = {vf_[4 * k4_].x, vf_[4 * k4_].y, vf_[4 * k4_ + 1].x, vf_[4 * k4_ + 1].y}, vb_ = {vf_[4 * k4_ + 2].x, vf_[4 * k4_ + 2].y, vf_[4 * k4_ + 3].x, vf_[4 * k4_ + 3].y}; \
        o0 = __builtin_amdgcn_mfma_f32_32x32x16_bf16(__builtin_bit_cast(bf16x8, va_), pb_, o0, 0, 0, 0); \
        o1 = __builtin_amdgcn_mfma_f32_32x32x16_bf16(__builtin_bit_cast(bf16x8, vb_), pb_, o1, 0, 0, 0); } } while (0)

__device__ __forceinline__ void attn_phase(const Params& p, LAS unsigned char* lds, int G) {
    unsigned char* ws = p.ws;
    const int tid = opaque_tid(), lane = tid & 63, wave = __builtin_amdgcn_readfirstlane(tid >> 6), l32 = lane & 31, hi = lane >> 5;
    const bf16_t* QRAW = (const bf16_t*)(ws + WS_QRAW); const bf16_t* KF = (const bf16_t*)(ws + WS_KF); const bf16_t* VT = (const bf16_t*)(ws + WS_VT);
    const float* COS = (const float*)(ws + WS_COS); const float* SIN = (const float*)(ws + WS_SIN);
    bf16_t* Y = (bf16_t*)(ws + WS_Y);
    const int kr0 = tid / 12, kc0 = tid - kr0 * 12;
    const int kr1 = (tid + 512) / 12, kc1 = (tid + 512) - kr1 * 12;
    const int kr2 = (tid + 1024) / 12, kc2 = (tid + 1024) - kr2 * 12;
    const int vr0 = tid >> 4, vc0 = tid & 15;
    float negsb;
    {
        float gq = fmaxf(fabsf(p.in[15][lane]), fabsf(p.in[15][64 + l32])), gk = fmaxf(fabsf(p.in[16][lane]), fabsf(p.in[16][64 + l32]));
#pragma unroll
        for (int o = 1; o < 64; o <<= 1) { gq = fmaxf(gq, __shfl_xor(gq, o)); gk = fmaxf(gk, __shfl_xor(gk, o)); }
        negsb = -(96.f * gq * gk * QSCALE);
    }
    f32x16 negv;
#pragma unroll
    for (int e = 0; e < 16; ++e) negv[e] = negsb;
    asm volatile("" : "+v"(negv));
    for (int it = blockIdx.x; it < 2048; it += G) {
        const int kk = it >> 8, cc = it & 255, bh = cc >> 1, set = cc & 1;
        const int qt = set ? (14 - 2 * kk + (kk & 1)) : (15 - 2 * kk - (kk & 1));
        const int q0 = qt * 256 + 32 * wave, lim = q0 >> 6, nkt = 4 * qt + 4;
        const bf16_t* kbase = KF + (size_t)bh * SEQ * 96; const bf16_t* vbase = VT + (size_t)bh * 64 * SEQ;
        u32x4 rk0, rk1, rk2, rv0, rv1;
        ATT_LOAD(0);
        bf16x8 qf[6];
        {
            const size_t qrow = (size_t)(bh >> 3) * SEQ + q0 + l32;
            const bf16_t* qp = QRAW + qrow * 768 + (bh & 7) * 96 + 8 * hi;
            u32x4 qr[6];
#pragma unroll
            for (int ks = 0; ks < 6; ++ks) qr[ks] = *(const u32x4*)(qp + 16 * ks);
            const f32x4 c0 = *(const f32x4*)(COS + qrow * 16 + 8 * hi), c1 = *(const f32x4*)(COS + qrow * 16 + 8 * hi + 4);
            const f32x4 n0 = *(const f32x4*)(SIN + qrow * 16 + 8 * hi), n1 = *(const f32x4*)(SIN + qrow * 16 + 8 * hi + 4);
            f32x4 xa[6], xb[6]; float ss = 0.f;
#pragma unroll
            for (int ks = 0; ks < 6; ++ks) { xa[ks] = (f32x4){bflo(qr[ks].x), bfhi(qr[ks].x), bflo(qr[ks].y), bfhi(qr[ks].y)}; xb[ks] = (f32x4){bflo(qr[ks].z), bfhi(qr[ks].z), bflo(qr[ks].w), bfhi(qr[ks].w)};
                ss += sq4(xa[ks]) + sq4(xb[ks]); }
            ss += __shfl_xor(ss, 32);
            const float r = QSCALE / sqrtf(ss * (1.f / 96.f) + EPS);
#pragma unroll
            for (int ks = 0; ks < 6; ++ks) { const f32x4 ga = *(const f32x4*)(p.in[15] + 16 * ks + 8 * hi), gb = *(const f32x4*)(p.in[15] + 16 * ks + 8 * hi + 4);
                xa[ks] = xa[ks] * ga * r; xb[ks] = xb[ks] * gb * r; }
            const f32x4 ra = xa[4] * c0 - xa[5] * n0, rb = xb[4] * c1 - xb[5] * n1, rc = xa[5] * c0 + xa[4] * n0, rd = xb[5] * c1 + xb[4] * n1;
            xa[4] = ra; xb[4] = rb; xa[5] = rc; xb[5] = rd;
#pragma unroll
            for (int ks = 0; ks < 6; ++ks) qf[ks] = __builtin_bit_cast(bf16x8, pack8(xa[ks], xb[ks]));
        }
        f32x16 o0, o1;
#pragma unroll
        for (int e = 0; e < 16; ++e) { o0[e] = 0.f; o1[e] = 0.f; }
        float lsum = 0.f;
        const int nst = nkt >> 1;
        ATT_STORE(0);
        LBAR();
        for (int st = 0; st < nst; ++st) {
            const int buf = st & 1; const bool more = (st + 1 < nst);
            if (more) ATT_LOAD(st + 1);
            if (2 * st <= lim) ATT_COMPUTE(buf, 0);
            if (2 * st + 1 <= lim) ATT_COMPUTE(buf, 1);
            if (more) ATT_STORE(buf ^ 1);
            LBAR();
        }
        lsum += __shfl_xor(lsum, 32);
        const float inv = 1.0f / lsum;
        const int b = bh >> 3, h = bh & 7;
        {
            const f32x16 q0v = o0 * inv, q1v = o1 * inv; float yss = 0.f;
#pragma unroll
            for (int e = 0; e < 16; ++e) yss += q0v[e] * q0v[e] + q1v[e] * q1v[e];
            yss += __shfl_xor(yss, 32);
            if (hi == 0) unsafeAtomicAdd((float*)(ws + WS_SS) + 6 * M + (size_t)b * SEQ + q0 + l32, yss);
        }
        bf16_t* yp = Y + ((size_t)b * SEQ + q0 + l32) * 1024 + 512 + h * 64 + 4 * hi;
#pragma unroll
        for (int j4 = 0; j4 < 4; ++j4) {
            u32x2 w0, w1;
            w0.x = cvt_pk(o0[4 * j4] * inv, o0[4 * j4 + 1] * inv); w0.y = cvt_pk(o0[4 * j4 + 2] * inv, o0[4 * j4 + 3] * inv);
            w1.x = cvt_pk(o1[4 * j4] * inv, o1[4 * j4 + 1] * inv); w1.y = cvt_pk(o1[4 * j4 + 2] * inv, o1[4 * j4 + 3] * inv);
            *(u32x2*)(yp + 8 * j4) = w0; *(u32x2*)(yp + 32 + 8 * j4) = w1;
        }
    }
}


#define XB_TMO      128
#define XB_XCNT(j)  (256  + 64 * (j))
#define XB_XSUB(j)  (1280 + 64 * (j))
#define XB_XGEN(j)  (2304 + 64 * (j))
#define XB_TOP      3328
#define XB_TOPGEN   3392
#define XCD_BAR_WORDS 3456
#define XB_SPIN_CAP (1u << 18)

__device__ __forceinline__ unsigned xb_ld(unsigned* p)              { return __hip_atomic_load(p, __ATOMIC_RELAXED, __HIP_MEMORY_SCOPE_AGENT); }
__device__ __forceinline__ unsigned xb_add(unsigned* p, unsigned v) { return __hip_atomic_fetch_add(p, v, __ATOMIC_RELAXED, __HIP_MEMORY_SCOPE_AGENT); }
__device__ __forceinline__ unsigned xb_xcc_id() { return (unsigned)__builtin_amdgcn_s_getreg((3 << 11) | 20) & 0xFu; }
#define XB_SPIN(cond, bar) do { unsigned _sp = 0; while (cond) { __builtin_amdgcn_s_sleep(1); \
    if ((++_sp & 255u) == 0u) { if (xb_ld(&(bar)[XB_TMO])) break; if (_sp > XB_SPIN_CAP) { atomicAdd(&(bar)[XB_TMO], 1u); break; } } } } while (0)

struct XcdBarrier {
    unsigned* bar; unsigned x;
    volatile LAS unsigned* st;
};

__device__ __forceinline__ XcdBarrier xcd_barrier_post(unsigned* bar, volatile LAS unsigned* st) {
    XcdBarrier b; b.bar = bar; b.x = xb_xcc_id(); b.st = st;
    if (threadIdx.x == 0) (void)xb_add(&bar[XB_XCNT(b.x)], 1u);
    return b;
}
__device__ __forceinline__ void xcd_barrier_complete(unsigned* bar, unsigned x, unsigned& nloc, unsigned& nx) {
    const unsigned G = gridDim.x * gridDim.y * gridDim.z;
    unsigned sum, cnt, mine, sp = 0u;
    for (;;) {
        sum = 0u; cnt = 0u; mine = 0u;
#pragma unroll
        for (unsigned j = 0; j < 16; ++j) { const unsigned c = xb_ld(&bar[XB_XCNT(j)]); sum += c; cnt += (c > 0u) ? 1u : 0u; mine = (j == x) ? c : mine; }
        if (sum == G) break;
        __builtin_amdgcn_s_sleep(1);
        if ((++sp & 255u) == 0u) { if (xb_ld(&bar[XB_TMO])) break; if (sp > XB_SPIN_CAP) { atomicAdd(&bar[XB_TMO], 1u); break; } }
    }
    nloc = mine > 0u ? mine : 1u; nx = cnt > 0u ? cnt : 1u;
}

__device__ __forceinline__ void xcd_barrier(const XcdBarrier& b) {
    asm volatile("s_waitcnt vmcnt(0)" ::: "memory");
    __syncthreads();
    if (threadIdx.x == 0) {
        unsigned* bar = b.bar;
        __builtin_amdgcn_s_waitcnt(0);
        unsigned nloc = b.st[0], nx = b.st[1];
        if (nloc == 0u) { xcd_barrier_complete(bar, b.x, nloc, nx); b.st[0] = nloc; b.st[1] = nx; }
        const unsigned old = xb_add(&bar[XB_XSUB(b.x)], 1u);
        const unsigned gen = old / nloc;
        if (old + 1u == (gen + 1u) * nloc) {
            __builtin_amdgcn_fence(__ATOMIC_RELEASE, "agent");
            asm volatile("s_waitcnt vmcnt(0)" ::: "memory");
            const unsigned og = xb_add(&bar[XB_TOP], 1u);
            const unsigned tg = og / nx;
            if (og + 1u == (tg + 1u) * nx) xb_add(&bar[XB_TOPGEN], 1u);
            else XB_SPIN(xb_ld(&bar[XB_TOPGEN]) == tg, bar);
            __builtin_amdgcn_fence(__ATOMIC_ACQUIRE, "agent");
            xb_add(&bar[XB_XGEN(b.x)], 1u);
            asm volatile("s_waitcnt vmcnt(0)" ::: "memory");
        } else {
            XB_SPIN(xb_ld(&bar[XB_XGEN(b.x)]) == gen, bar);
            __builtin_amdgcn_fence(__ATOMIC_ACQUIRE, "agent");
            asm volatile("s_waitcnt vmcnt(0)" ::: "memory");
        }
    }
    __syncthreads();
}


__device__ __forceinline__ void grid_bar(unsigned* ctr, unsigned target) {
    asm volatile("s_waitcnt vmcnt(0) lgkmcnt(0)" ::: "memory");
    __syncthreads();
    if (threadIdx.x == 0) {
        __builtin_amdgcn_fence(__ATOMIC_RELEASE, "agent");
        __hip_atomic_fetch_add(ctr, 1u, __ATOMIC_RELAXED, __HIP_MEMORY_SCOPE_AGENT);
        unsigned spins = 0;
        while (__hip_atomic_load(ctr, __ATOMIC_RELAXED, __HIP_MEMORY_SCOPE_AGENT) < target && ++spins < (1u << 24)) __builtin_amdgcn_s_sleep(2);
    }
    __syncthreads();
    __builtin_amdgcn_fence(__ATOMIC_ACQUIRE, "agent");
}

constexpr int NPH = 12;
constexpr int NCH = 1, MCH = M / NCH;
#define REPMASK 0x0
#define RP(k) for (int rep = 0; rep < 1 + ((REPMASK >> (k)) & 1); ++rep)
#define RS do { if (rep) cg::this_grid().sync(); } while (0)
__global__ void __launch_bounds__(512, 2) mk_fwd(Params p) {
    extern __shared__ __attribute__((aligned(16))) unsigned char smem[];
    LAS unsigned char* lds = (LAS unsigned char*)smem;
    const int G = gridDim.x;
    unsigned char* ws = p.ws;
    const int lo = p.ph_lo, hi = p.ph_hi;
#define IN(k) (lo <= (k) && (k) < hi)
#define SEAM(k) do { if (IN(k) && IN((k) + 1)) xcd_barrier(xbar); } while (0)
    bf16_t* XN = (bf16_t*)(ws + WS_XN); bf16_t* HID = (bf16_t*)(ws + WS_HID); bf16_t* Y = (bf16_t*)(ws + WS_Y);
    volatile LAS unsigned* xst = (volatile LAS unsigned*)(lds + 131072);
    if (threadIdx.x == 0) { xst[0] = 0u; xst[1] = 0u; }
    __syncthreads();
    const XcdBarrier xbar = xcd_barrier_post((unsigned*)(ws + WS_BAR), xst);
    float* SS1 = (float*)(ws + WS_SS); float* SS2 = SS1 + M; float* SS3 = SS2 + M; float* SSQ = SS3 + M; float* SSKV = SSQ + M;

    if (lo < 0) cg::this_grid().sync();
    if (IN(0)) RP(0) { RS; p0_prologue(p, lds, G); } SEAM(0);
    for (int ch = 0; ch < NCH; ++ch) {
        const size_t r0 = (size_t)ch * MCH;
        if (IN(1)) {
            pg8::Gemm g{XN + r0 * D, (const bf16_t*)(ws + WS_WGU1), MCH, NGU, D}; pg8::StaticOrder S; S.init(MCH, NGU, G, (int)blockIdx.x);
            EpiSwiglu<false> E{HID + r0 * FF, nullptr}; pg8::gemm_phase<EpiSwiglu<false>, pg8::StaticOrder, true, true>(lds, g, S, E);
        }
        if (IN(1) && IN(2)) xcd_barrier(xbar);
        if (IN(2)) {
            pg8::Gemm g{HID + r0 * FF, (const bf16_t*)(ws + WS_WD1), MCH, D, FF}; pg8::StaticOrder S; S.init(MCH, D, G, (int)blockIdx.x);
            EpiResid<true> E{p.in[0] + r0 * D, XN + r0 * D, SS1 + r0, 0.5f}; pg8::gemm_phase<EpiResid<true>, pg8::StaticOrder, true, true, true>(lds, g, S, E);
        }
        if (IN(1) && IN(2)) xcd_barrier(xbar);
    }
    if (IN(3)) {
        pg8::Gemm g{XN, (const bf16_t*)(ws + WS_WIN), M, NINP, D}; pg8::StaticOrder S; S.init(M, NINP, G, (int)blockIdx.x);
        EpiH E{(bf16_t*)(ws + WS_GU), (bf16_t*)(ws + WS_GV), (bf16_t*)(ws + WS_CQN), (bf16_t*)(ws + WS_CKVN), (float*)(ws + WS_KR), SS1, SSQ, SSKV};
        pg8::gemm_phase<EpiH, pg8::StaticOrder, true, true>(lds, g, S, E);
    } SEAM(3);
    if (IN(4)) RP(4) { RS;
        { pg8::Gemm g{(const bf16_t*)(ws + WS_CQN), (const bf16_t*)(ws + WS_WUQ), M, 768, 256}; pg8::StaticOrder S; S.init(M, 768, G, (int)blockIdx.x);
          EpiPlain E{(bf16_t*)(ws + WS_QRAW), 768, SSQ, 1.f / 256.f}; pg8::gemm_phase<EpiPlain, pg8::StaticOrder, true, true>(lds, g, S, E); }
        { pg8::Gemm g{(const bf16_t*)(ws + WS_CKVN), (const bf16_t*)(ws + WS_WUKV), M, 1024, 128}; pg8::StaticOrder S; S.init(M, 1024, G, (int)blockIdx.x);
          EpiPlain E{(bf16_t*)(ws + WS_KVRAW), 1024, SSKV, 1.f / 128.f}; pg8::gemm_phase<EpiPlain, pg8::StaticOrder, true, true>(lds, g, S, E); }
    } SEAM(4);
    if (IN(5)) RP(5) { RS; finalize_phase(p, lds, G); } SEAM(5);
    if (IN(6)) RP(6) { RS; attn_phase(p, lds, G); gmlp_phase(p, lds, G); } SEAM(6);
    if (IN(8)) {
        pg8::Gemm g{Y, (const bf16_t*)(ws + WS_WOUT), M, D, D}; OrderY S; S.init(M, D, G, (int)blockIdx.x); S.SSA = SS1 + 5 * M; S.SSB = SS1 + 6 * M; S.F = (LAS float*)(lds + 131072 + 64);
        EpiResidY E{XN, SS2, SS1 + 6 * M, (const LAS float*)(lds + 131072 + 64)}; pg8::gemm_phase<EpiResidY, OrderY, true, true>(lds, g, S, E);
    } SEAM(8);
    for (int ch = 0; ch < NCH; ++ch) {
        const size_t r0 = (size_t)ch * MCH;
        if (IN(9)) {
            pg8::Gemm g{XN + r0 * D, (const bf16_t*)(ws + WS_WGU2), MCH, NGU, D}; pg8::StaticOrder S; S.init(MCH, NGU, G, (int)blockIdx.x);
            EpiSwiglu<true> E{HID + r0 * FF, SS2 + r0}; pg8::gemm_phase<EpiSwiglu<true>, pg8::StaticOrder, true, true>(lds, g, S, E);
        }
        if (IN(9) && IN(10)) xcd_barrier(xbar);
        if (IN(10)) {
            pg8::Gemm g{HID + r0 * FF, (const bf16_t*)(ws + WS_WD2), MCH, D, FF}; pg8::StaticOrder S; S.init(MCH, D, G, (int)blockIdx.x);
            EpiResid<false> E{nullptr, XN + r0 * D, SS3 + r0, 0.5f}; pg8::gemm_phase<EpiResid<false>, pg8::StaticOrder, true, true, true>(lds, g, S, E);
        }
        if (IN(9) && IN(10)) xcd_barrier(xbar);
    }
    if (IN(11)) { final_phase(XN, SS3, p.in[24], p.out, G); }
#undef IN
#undef SEAM
}

extern "C" void kernel_launch(void* const* d_in, const int* in_sizes, int n_in, void* d_out, int out_size, void* d_ws, size_t ws_size, hipStream_t stream) {
    static int grid = 0;
    if (grid == 0) {
        if (n_in != 25 || out_size != M * D || ws_size < WS_END) { fprintf(stderr, "kernel_launch: unexpected shapes: n_in %d out %d ws %zu\n", n_in, out_size, ws_size); grid = -1; return; }
        int dev = 0, cus = 0, per_cu = 0;
        (void)hipGetDevice(&dev); (void)hipDeviceGetAttribute(&cus, hipDeviceAttributeMultiprocessorCount, dev);
        if (hipFuncSetAttribute((const void*)mk_fwd, hipFuncAttributeMaxDynamicSharedMemorySize, LDS_BYTES) != hipSuccess) { fprintf(stderr, "kernel_launch: hipFuncSetAttribute failed\n"); grid = -1; return; }
        if (hipOccupancyMaxActiveBlocksPerMultiprocessor(&per_cu, (const void*)mk_fwd, 512, LDS_BYTES) != hipSuccess || per_cu < 1) { fprintf(stderr, "kernel_launch: occupancy query says %d\n", per_cu); per_cu = 1; }
        (void)hipGetLastError();
        grid = cus * per_cu;
        fprintf(stderr, "kernel_launch: grid %d (%d CUs x %d)\n", grid, cus, per_cu);
    }
    if (grid < 0) return;
    Params p{};
    for (int i = 0; i < 25; ++i) p.in[i] = (const float*)d_in[i];
    p.out = (float*)d_out; p.ws = (unsigned char*)d_ws;
#if MK_COOP
    (void)hipMemsetAsync((unsigned char*)d_ws + WS_BAR, 0, 16384, stream);
    p.ph_lo = 0; p.ph_hi = NPH;
    void* args[] = {&p};
    hipError_t e = hipLaunchCooperativeKernel((const void*)mk_fwd, dim3(grid), dim3(512), args, LDS_BYTES, stream);
    if (e != hipSuccess) fprintf(stderr, "kernel_launch: cooperative launch failed: %s (grid %d)\n", hipGetErrorString(e), grid);
#else
    for (int ph = 0; ph < NPH; ++ph) {
        p.ph_lo = ph; p.ph_hi = ph + 1;
        hipLaunchKernelGGL(mk_fwd, dim3(grid), dim3(512), LDS_BYTES, stream, p);
    }
#endif
}
```
